# Optimizing an MI355X kernel written in HIP

```python
import math
import jax, jax.numpy as jnp
from jax import lax
import numpy as np

D_MODEL = 2048
BATCH = 16
SEQ = 2048
DEPTH = 4
DEC_BATCH = 8
DEC_SEQ = 2048
PAST_LEN = 128

HEAD_DIM = 128
WIN_Q_HEADS = 8
WIN_KV_HEADS = 2
WIN_REP = WIN_Q_HEADS // WIN_KV_HEADS
WINDOW = 128
BLOCK = 128
DIFF_HEADS = 4
DIFF_HEAD_DIM = 128
N_ALIBI_HEADS = WIN_Q_HEADS + DIFF_HEADS
WIN_Q = WIN_Q_HEADS * HEAD_DIM
WIN_KV = WIN_KV_HEADS * HEAD_DIM
DIFF_QK = DIFF_HEADS * 2 * DIFF_HEAD_DIM
DIFF_V = DIFF_HEADS * 2 * DIFF_HEAD_DIM
SPLIT_SIZES = (WIN_Q, WIN_KV, WIN_KV, DIFF_QK, DIFF_QK, DIFF_V, D_MODEL, D_MODEL)
IN_COLS = WIN_Q + 2 * WIN_KV + 2 * DIFF_QK + DIFF_V + 2 * D_MODEL
D_FF = ((8 * D_MODEL // 3 + 127) // 128) * 128
N_EXPERTS = 8
TOP_K = 2
D_FF_EXPERT = D_MODEL // 2
N_DENSE = (DEPTH + 1) // 2
N_MOE = DEPTH // 2
ALPHA = (2.0 * DEPTH) ** 0.25
BETA = (8.0 * DEPTH) ** -0.25
LN_EPS = 1e-5
NEG_INF = -1e30

kernel_name = 'hybrid_window_diff_alibi_deepnorm_encoder'


def _layer_norm(x, g, b):
    xf = x.astype(jnp.float32)
    mu = jnp.mean(xf, axis=-1, keepdims=True)
    xc = xf - mu
    var = jnp.mean(xc * xc, axis=-1, keepdims=True)
    return (xc * lax.rsqrt(var + LN_EPS) * g.astype(jnp.float32) + b.astype(jnp.float32)).astype(x.dtype)


def _rms_norm(x, g):
    xf = x.astype(jnp.float32)
    return (xf * lax.rsqrt(jnp.mean(xf * xf, axis=-1, keepdims=True) + LN_EPS) * g.astype(jnp.float32)).astype(x.dtype)


def _alibi_slopes():
    h = jnp.arange(1, N_ALIBI_HEADS + 1, dtype=jnp.float32)
    return jnp.exp2(-8.0 * h / N_ALIBI_HEADS)


def _split_columns(z):
    parts, start = [], 0
    for size in SPLIT_SIZES:
        parts.append(z[..., start:start + size])
        start += size
    return parts


def _window_attention(q, k, v, sink, slopes):
    B, S = q.shape[0], q.shape[1]
    nb = S // BLOCK
    qb = q.reshape(B, nb, BLOCK, WIN_KV_HEADS, WIN_REP, HEAD_DIM)
    pad = ((0, 0), (BLOCK, BLOCK), (0, 0), (0, 0))
    kp = jnp.pad(k, pad).reshape(B, nb + 2, BLOCK, WIN_KV_HEADS, HEAD_DIM)
    vp = jnp.pad(v, pad).reshape(B, nb + 2, BLOCK, WIN_KV_HEADS, HEAD_DIM)
    kw = jnp.concatenate([kp[:, :-2], kp[:, 1:-1], kp[:, 2:]], axis=2)
    vw = jnp.concatenate([vp[:, :-2], vp[:, 1:-1], vp[:, 2:]], axis=2)
    s = jnp.einsum('bnqgrd,bnkgd->bngrqk', qb, kw).astype(jnp.float32) * (HEAD_DIM ** -0.5)
    dist = jnp.abs(jnp.arange(BLOCK)[:, None] - jnp.arange(3 * BLOCK)[None, :] + BLOCK)
    key_pos = (jnp.arange(nb)[:, None] - 1) * BLOCK + jnp.arange(3 * BLOCK)[None, :]
    valid = (dist[None] <= WINDOW) & (key_pos[:, None, :] >= 0) & (key_pos[:, None, :] < S)
    s = s - slopes.astype(jnp.float32)[:, :, None, None] * dist.astype(jnp.float32)
    s = jnp.where(valid[None, :, None, None], s, NEG_INF)
    sink_l = sink.astype(jnp.float32)[None, None, :, :, None]
    m = jnp.maximum(jnp.max(s, axis=-1), sink_l)
    p = jnp.exp(s - m[..., None])
    denom = jnp.sum(p, axis=-1) + jnp.exp(sink_l - m)
    p = p / denom[..., None]
    out = jnp.einsum('bngrqk,bnkgd->bnqgrd', p.astype(vw.dtype), vw)
    return out.reshape(B, S, WIN_Q)


def _diff_attention(q, k, v, lam, slopes):
    B, S = q.shape[0], q.shape[1]
    nb = S // BLOCK
    qb = jnp.moveaxis(q.reshape(B, nb, BLOCK, DIFF_HEADS, 2, DIFF_HEAD_DIM), 1, 0)
    key_pos = jnp.arange(S)
    sl = slopes.astype(jnp.float32)[:, None, None, None]

    def one_block(args):
        q_blk, n = args
        s = jnp.einsum('bqhcd,bkhcd->bhcqk', q_blk, k).astype(jnp.float32) * (DIFF_HEAD_DIM ** -0.5)
        dist = jnp.abs(n * BLOCK + jnp.arange(BLOCK)[:, None] - key_pos[None, :]).astype(jnp.float32)
        a = jax.nn.softmax(s - sl * dist, axis=-1)
        w = a[:, :, 0] - lam * a[:, :, 1]
        return jnp.einsum('bhqk,bkhe->bqhe', w.astype(v.dtype), v)

    out = lax.map(one_block, (qb, jnp.arange(nb)))
    return jnp.moveaxis(out, 0, 1).reshape(B, S, DIFF_HEADS, 2 * DIFF_HEAD_DIM)


def _mixer(x, w_in, sink, lq1, lk1, lq2, lk2, subln_g, w_pa, w_pd, w_o, lambda_init):
    B, S, _ = x.shape
    z = x @ w_in
    qa, ka, va, qd, kd, vd, ga, gd = _split_columns(z)
    slopes = _alibi_slopes()
    ya = _window_attention(
        qa.reshape(B, S, WIN_KV_HEADS, WIN_REP, HEAD_DIM),
        ka.reshape(B, S, WIN_KV_HEADS, HEAD_DIM),
        va.reshape(B, S, WIN_KV_HEADS, HEAD_DIM),
        sink.reshape(WIN_KV_HEADS, WIN_REP),
        slopes[:WIN_Q_HEADS].reshape(WIN_KV_HEADS, WIN_REP))
    lam = (jnp.exp(jnp.sum(lq1.astype(jnp.float32) * lk1.astype(jnp.float32)))
           - jnp.exp(jnp.sum(lq2.astype(jnp.float32) * lk2.astype(jnp.float32))) + lambda_init)
    yd = _diff_attention(
        qd.reshape(B, S, DIFF_HEADS, 2, DIFF_HEAD_DIM),
        kd.reshape(B, S, DIFF_HEADS, 2, DIFF_HEAD_DIM),
        vd.reshape(B, S, DIFF_HEADS, 2 * DIFF_HEAD_DIM),
        lam, slopes[WIN_Q_HEADS:])
    yd = (_rms_norm(yd, subln_g) * (1.0 - lambda_init)).reshape(B, S, DIFF_V)
    merged = jax.nn.sigmoid(ga) * (ya @ w_pa) + jax.nn.sigmoid(gd) * (yd @ w_pd)
    return merged @ w_o


def _swiglu(h, w1, w3, w2):
    return (jax.nn.silu(h @ w1) * (h @ w3)) @ w2


def _moe(h, w_router, w1, w3, w2):
    logits = jnp.einsum('bsd,de->bse', h, w_router).astype(jnp.float32)
    top_val, top_idx = lax.top_k(logits, TOP_K)
    gates = jax.nn.softmax(top_val, axis=-1)
    comb = jnp.sum(gates[..., None] * jax.nn.one_hot(top_idx, N_EXPERTS, dtype=jnp.float32), axis=-2)
    y = jnp.zeros_like(h)
    for e in range(N_EXPERTS):
        y = y + comb[..., e:e + 1].astype(h.dtype) * _swiglu(h, w1[e], w3[e], w2[e])
    return y


def setup_inputs(seed: int = 0) -> dict:
    key = jax.random.key(seed)
    ks = jax.random.split(key, 26)
    f32 = jnp.float32

    def nrm(k, shape, scale):
        return jax.random.normal(k, shape, f32) * scale

    col_scale = jnp.concatenate([
        jnp.ones((WIN_Q + WIN_KV,), f32), jnp.full((WIN_KV,), BETA, f32),
        jnp.ones((2 * DIFF_QK,), f32), jnp.full((DIFF_V,), BETA, f32),
        jnp.ones((2 * D_MODEL,), f32)])
    return {
        'x_prompt': nrm(ks[0], (BATCH, SEQ, D_MODEL), 1.0),
        'x_sample': nrm(ks[1], (DEC_BATCH, DEC_SEQ, D_MODEL), 1.0),
        'ln_emb_g': 1.0 + nrm(ks[2], (D_MODEL,), 0.02),
        'ln_emb_b': nrm(ks[3], (D_MODEL,), 0.02),
        'w_in': nrm(ks[4], (DEPTH, D_MODEL, IN_COLS), D_MODEL ** -0.5) * col_scale,
        'sink': nrm(ks[5], (DEPTH, WIN_Q_HEADS), 0.5),
        'lambda_q1': nrm(ks[6], (DEPTH, DIFF_HEAD_DIM), 0.1),
        'lambda_k1': nrm(ks[7], (DEPTH, DIFF_HEAD_DIM), 0.1),
        'lambda_q2': nrm(ks[8], (DEPTH, DIFF_HEAD_DIM), 0.1),
        'lambda_k2': nrm(ks[9], (DEPTH, DIFF_HEAD_DIM), 0.1),
        'subln_g': 1.0 + nrm(ks[10], (DEPTH, 2 * DIFF_HEAD_DIM), 0.02),
        'w_pa': nrm(ks[11], (DEPTH, WIN_Q, D_MODEL), WIN_Q ** -0.5 * BETA),
        'w_pd': nrm(ks[12], (DEPTH, DIFF_V, D_MODEL), DIFF_V ** -0.5 * BETA),
        'w_o': nrm(ks[13], (DEPTH, D_MODEL, D_MODEL), D_MODEL ** -0.5 * BETA),
        'ln1_g': 1.0 + nrm(ks[14], (DEPTH, D_MODEL), 0.02),
        'ln1_b': nrm(ks[15], (DEPTH, D_MODEL), 0.02),
        'ln2_g': 1.0 + nrm(ks[16], (DEPTH, D_MODEL), 0.02),
        'ln2_b': nrm(ks[17], (DEPTH, D_MODEL), 0.02),
        'ffn_w1': nrm(ks[18], (N_DENSE, D_MODEL, D_FF), D_MODEL ** -0.5 * BETA),
        'ffn_w3': nrm(ks[19], (N_DENSE, D_MODEL, D_FF), D_MODEL ** -0.5 * BETA),
        'ffn_w2': nrm(ks[20], (N_DENSE, D_FF, D_MODEL), D_FF ** -0.5 * BETA),
        'router_w': nrm(ks[21], (N_MOE, D_MODEL, N_EXPERTS), D_MODEL ** -0.5),
        'moe_w1': nrm(ks[22], (N_MOE, N_EXPERTS, D_MODEL, D_FF_EXPERT), D_MODEL ** -0.5 * BETA),
        'moe_w3': nrm(ks[23], (N_MOE, N_EXPERTS, D_MODEL, D_FF_EXPERT), D_MODEL ** -0.5 * BETA),
        'moe_w2': nrm(ks[24], (N_MOE, N_EXPERTS, D_FF_EXPERT, D_MODEL), D_FF_EXPERT ** -0.5 * BETA),
    }


def reference(x_prompt, x_sample, ln_emb_g, ln_emb_b, w_in, sink, lambda_q1, lambda_k1, lambda_q2, lambda_k2,
              subln_g, w_pa, w_pd, w_o, ln1_g, ln1_b, ln2_g, ln2_b, ffn_w1, ffn_w3, ffn_w2, router_w,
              moe_w1, moe_w3, moe_w2):
    def trunk(x):
        x = _layer_norm(x, ln_emb_g, ln_emb_b)
        for l in range(DEPTH):
            lambda_init = 0.8 - 0.6 * math.exp(-0.3 * l)
            mix = _mixer(x, w_in[l], sink[l], lambda_q1[l], lambda_k1[l], lambda_q2[l], lambda_k2[l],
                         subln_g[l], w_pa[l], w_pd[l], w_o[l], lambda_init)
            h = _layer_norm(ALPHA * x + mix, ln1_g[l], ln1_b[l])
            i = l // 2
            if l % 2 == 0:
                f = _swiglu(h, ffn_w1[i], ffn_w3[i], ffn_w2[i])
            else:
                f = _moe(h, router_w[i], moe_w1[i], moe_w3[i], moe_w2[i])
            x = _layer_norm(ALPHA * h + f, ln2_g[l], ln2_b[l])
        return x

    y_prompt = trunk(x_prompt)
    y_sample = trunk(x_sample)
    return (y_prompt, y_sample)
```

```cpp
#include <hip/hip_runtime.h>
#include <hip/hip_bf16.h>
#include <cstdio>
#include <cstdint>
#include <cmath>

#ifndef MK_PER_PHASE
#define MK_PER_PHASE 0
#endif

namespace pg8 {
#define PG8_LAS __attribute__((address_space(3)))
typedef unsigned short bf16_t;
typedef short bf16x8 __attribute__((ext_vector_type(8)));
typedef float f32x4 __attribute__((ext_vector_type(4)));
typedef unsigned u32x4 __attribute__((ext_vector_type(4)));
constexpr int BM = 256, BK = 64, HALF = 128, HTB = HALF * BK * 2  , STAGE_BYTES = 8 * HTB, NXCD = 8, WGM = 8;

__host__ __device__ __forceinline__ int lds_byte(int r, int c) { const int st = (r >> 4) * 2 + (c >> 5), rr = r & 15, cc = c & 31, ob = rr * 64 + cc * 2; return st * 1024 + (ob ^ (((ob >> 9) & 1) << 5)); }
__host__ __device__ __forceinline__ void stage_rc(int b, int& R, int& C) { const int st = b / 1024, sb = b % 1024, swz = sb ^ (((sb >> 9) & 1) << 5); R = (st >> 1) * 16 + swz / 64; C = (st & 1) * 32 + (swz % 64) / 2; }
__host__ __device__ __forceinline__ int perm32(int rho) { const int n = rho >> 4, i = rho & 15; return 8 * (i >> 2) + 4 * n + (i & 3); }

struct Unit { int pm, pn; };
struct Gemm { const bf16_t* A; const bf16_t* Bt; int M, N, K; };

struct StaticOrder {
    int nM, nN, nwg, G, c;
    __host__ __device__ void init(int M, int N, int G_, int c_) { nM = M / BM; nN = N / BM; nwg = nM * nN; G = G_; c = c_; }
    __host__ __device__ bool next(int i, Unit& u) const {
        const long L = (long)i * G + c; if (L >= nwg) return false;
        int wgid = (int)L; { const int q = nwg / NXCD, r = nwg % NXCD, xcd = wgid % NXCD, off = wgid / NXCD; wgid = (xcd < r ? xcd * (q + 1) : r * (q + 1) + (xcd - r) * q) + off; }
        const int nig = WGM * nN, gid = wgid / nig, fm = gid * WGM, gsz = (nM - fm) < WGM ? (nM - fm) : WGM;
        u.pm = fm + ((wgid % nig) % gsz); u.pn = (wgid % nig) / gsz; return true;
    }
    __device__ __forceinline__ void a_ready(const Unit&) const {}
    __device__ __forceinline__ void done(const Unit&) const {}
};


__device__ __forceinline__ unsigned cvt_pk_bf16(float lo, float hi) { unsigned r; asm volatile("v_cvt_pk_bf16_f32 %0, %1, %2" : "=v"(r) : "v"(lo), "v"(hi)); return r; }
__device__ __forceinline__ float bf_lo(unsigned w) { return __uint_as_float(w << 16); }
__device__ __forceinline__ float bf_hi(unsigned w) { return __uint_as_float(w & 0xffff0000u); }
__device__ __forceinline__ float sigmoidf_fast(float x) { return __builtin_amdgcn_rcpf(1.0f + __builtin_amdgcn_exp2f(-1.4426950408889634f * x)); }
__device__ __forceinline__ u32x4 pack8(f32x4 v0, f32x4 v1) { u32x4 w; w.x = cvt_pk_bf16(v0[0], v0[1]); w.y = cvt_pk_bf16(v0[2], v0[3]); w.z = cvt_pk_bf16(v1[0], v1[1]); w.w = cvt_pk_bf16(v1[2], v1[3]); return w; }

struct EpiPlain {
    static constexpr bool PERM = true, AFTER_DRAIN = false;
    bf16_t* O; int ldc; int pn_mask; int gate_pn0; unsigned qmask; float qscale;
    __device__ __forceinline__ void operator()(const f32x4 (&acc)[2][2][4][2], const Unit& u, int wr, int wc, int fr, int fq) const {
        const int row0 = u.pm * BM + wr * 64 + fr; const int col0 = (u.pn & pn_mask) * BM + wc * 32 + 8 * fq; const bool sg = u.pn >= gate_pn0;
        const float sc = (u.pn < 32 && ((qmask >> u.pn) & 1u)) ? qscale : 1.0f;
#pragma unroll
        for (int ai = 0; ai < 2; ++ai)
#pragma unroll
            for (int m = 0; m < 4; ++m) { bf16_t* rowp = O + (size_t)(row0 + ai * HALF + m * 16) * ldc + col0;
#pragma unroll
                for (int bj = 0; bj < 2; ++bj) { f32x4 v0 = acc[ai][bj][m][0] * sc, v1 = acc[ai][bj][m][1] * sc;
                    if (sg) {
#pragma unroll
                        for (int k = 0; k < 4; ++k) { v0[k] = sigmoidf_fast(v0[k]); v1[k] = sigmoidf_fast(v1[k]); } }
                    *(u32x4*)(rowp + bj * HALF) = pack8(v0, v1); } }
    }
};
struct EpiGate {
    static constexpr bool PERM = true, AFTER_DRAIN = false;
    const bf16_t* G; int ldg; bf16_t* O; int ldc; int nM;
    __device__ __forceinline__ void operator()(const f32x4 (&acc)[2][2][4][2], const Unit& u, int wr, int wc, int fr, int fq) const {
        const int part = u.pn >= 8 ? 1 : 0; const int pm = u.pm - part * nM, pn = u.pn - part * 8;
        const int row0 = pm * BM + wr * 64 + fr; const int col0 = pn * BM + wc * 32 + 8 * fq;
#pragma unroll
        for (int ai = 0; ai < 2; ++ai)
#pragma unroll
            for (int m = 0; m < 4; ++m) { const size_t row = (size_t)(row0 + ai * HALF + m * 16);
#pragma unroll
                for (int bj = 0; bj < 2; ++bj) { f32x4 v0 = acc[ai][bj][m][0], v1 = acc[ai][bj][m][1];
                    const u32x4 g = *(const u32x4*)(G + row * ldg + part * 2048 + col0 + bj * HALF);
                    v0[0] *= bf_lo(g.x); v0[1] *= bf_hi(g.x); v0[2] *= bf_lo(g.y); v0[3] *= bf_hi(g.y);
                    v1[0] *= bf_lo(g.z); v1[1] *= bf_hi(g.z); v1[2] *= bf_lo(g.w); v1[3] *= bf_hi(g.w);
                    bf16_t* op = O + row * ldc + col0 + bj * HALF;
                    if (part) { const u32x4 p = *(const u32x4*)op;
                        v0[0] += bf_lo(p.x); v0[1] += bf_hi(p.x); v0[2] += bf_lo(p.y); v0[3] += bf_hi(p.y);
                        v1[0] += bf_lo(p.z); v1[1] += bf_hi(p.z); v1[2] += bf_lo(p.w); v1[3] += bf_hi(p.w); }
                    *(u32x4*)op = pack8(v0, v1); }
                if (m & 1) asm volatile("" ::: "memory"); }
    }
};
struct EpiSwiGlu {
    static constexpr bool PERM = true, AFTER_DRAIN = false;
    bf16_t* O; int ldc; int pn_mask; const float* rowgate;
    __device__ __forceinline__ void operator()(const f32x4 (&acc)[2][2][4][2], const Unit& u, int wr, int wc, int fr, int fq) const {
        const int row0 = u.pm * BM + wr * 64 + fr; const int col0 = (u.pn & pn_mask) * HALF + wc * 32 + 8 * fq;
#pragma unroll
        for (int ai = 0; ai < 2; ++ai)
#pragma unroll
            for (int m = 0; m < 4; ++m) { const size_t row = (size_t)(row0 + ai * HALF + m * 16);
                const float rg = rowgate ? rowgate[row] : 1.0f;
                f32x4 v0, v1;
#pragma unroll
                for (int k = 0; k < 4; ++k) { const float a0 = acc[ai][0][m][0][k], a1 = acc[ai][0][m][1][k];
                    v0[k] = a0 * sigmoidf_fast(a0) * acc[ai][1][m][0][k] * rg; v1[k] = a1 * sigmoidf_fast(a1) * acc[ai][1][m][1][k] * rg; }
                *(u32x4*)(O + row * ldc + col0) = pack8(v0, v1); }
    }
};
struct PairOrder {
    StaticOrder so;
    __device__ void init(int M, int G_, int c_) { so.init(M, 2048, G_, c_); }
    __device__ bool next(int i, Unit& u) const { Unit t; if (!so.next(i >> 1, t)) return false; const int part = i & 1; u.pm = t.pm + part * so.nM; u.pn = t.pn + part * so.nN; return true; }
    __device__ __forceinline__ void a_ready(const Unit&) const {}
    __device__ __forceinline__ void done(const Unit&) const {}
};
struct MoeOrder {
    int po1, po2, po3, po4, po5, po6, po7, P, G, c;
    __device__ bool next(int i, Unit& u) const {
        const int L = i * G + c; if (L >= P * 8) return false;
        const int p = L >> 3, t = L & 7;
        const int e = (p >= po1) + (p >= po2) + (p >= po3) + (p >= po4) + (p >= po5) + (p >= po6) + (p >= po7);
        u.pm = p; u.pn = e * 8 + t; return true;
    }
    __device__ __forceinline__ void a_ready(const Unit&) const {}
    __device__ __forceinline__ void done(const Unit&) const {}
};

template <class Epi, class Sched, bool ALIGN_EPI = false, bool SP2 = false>
__device__ __forceinline__ void gemm_phase(PG8_LAS unsigned char* lds, const Gemm g, const Sched& S, const Epi& E) {
    int tid_ = threadIdx.x; asm volatile("" : "+v"(tid_));
    const int tid = tid_, wid = __builtin_amdgcn_readfirstlane(tid >> 6), lane = tid & 63, wr = wid >> 2, wc = wid & 3, fr = lane & 15, fq = lane >> 4;
    const int K = g.K, nt = K / BK;
    unsigned voffA[2], voffB[2];
#pragma unroll
    for (int i = 0; i < 2; ++i) { int R, C; stage_rc(tid * 16 + i * 8192, R, C); const int Rb = Epi::PERM ? ((R & ~31) + perm32(R & 31)) : R;
        voffA[i] = (unsigned)(R * K + C) * 2u; voffB[i] = (unsigned)(Rb * K + C) * 2u; }
    const size_t kstep = (size_t)(BK * 2);
    const size_t hstep = (size_t)HALF * K * 2;
    const size_t tstep = 2 * hstep;
    const unsigned ldsw = (unsigned)wid * 1024u;
    const int aoff = lds_byte(wr * 64 + fr, fq * 8), boff = lds_byte(wc * 32 + fr, fq * 8);
#define PG8_SA(b, h) (((b) * 2 + (h)) * HTB)
#define PG8_SB(b, h) ((4 + (b) * 2 + (h)) * HTB)
#define PG8_STAGE(bufoff, gbase, voff) do { _Pragma("unroll") for (int _i = 0; _i < 2; ++_i) \
        __builtin_amdgcn_global_load_lds((const unsigned*)((const char*)(gbase) + (voff)[_i]), (PG8_LAS unsigned*)(lds + (bufoff) + ldsw + _i * 8192), 16, 0, 0); } while (0)
#define PG8_LDA(dst, b, h) do { _Pragma("unroll") for (int m = 0; m < 4; ++m) _Pragma("unroll") for (int k = 0; k < 2; ++k) dst[m][k] = *(const PG8_LAS bf16x8*)(lds + PG8_SA(b, h) + aoff + m * 2048 + k * 1024); } while (0)
#define PG8_LDB(dst, b, h) do { _Pragma("unroll") for (int n = 0; n < 2; ++n) _Pragma("unroll") for (int k = 0; k < 2; ++k) dst[n][k] = *(const PG8_LAS bf16x8*)(lds + PG8_SB(b, h) + boff + n * 2048 + k * 1024); } while (0)
#define PG8_MMA(ai, bj, At, Bt) do { __builtin_amdgcn_s_setprio(1); _Pragma("unroll") for (int m = 0; m < 4; ++m) _Pragma("unroll") for (int n = 0; n < 2; ++n) _Pragma("unroll") for (int k = 0; k < 2; ++k) \
        acc[ai][bj][m][n] = __builtin_amdgcn_mfma_f32_16x16x32_bf16(Bt[n][k], At[m][k], acc[ai][bj][m][n], 0, 0, 0); __builtin_amdgcn_s_setprio(0); } while (0)
#define PG8_WAIT_V(n) asm volatile("s_waitcnt vmcnt(" #n ")" ::: "memory")
#define PG8_WAIT_L(n) asm volatile("s_waitcnt lgkmcnt(" #n ")" ::: "memory")
#define PG8_BAR __builtin_amdgcn_s_barrier()
#define PG8_SCHED __builtin_amdgcn_sched_barrier(0)
    Unit cur, nxt; int ui = 0;
    if (!S.next(0, cur)) return;
    f32x4 acc[2][2][4][2];
#pragma unroll
    for (int a = 0; a < 2; ++a)
#pragma unroll
        for (int b = 0; b < 2; ++b)
#pragma unroll
            for (int m = 0; m < 4; ++m)
#pragma unroll
                for (int n = 0; n < 2; ++n) acc[a][b][m][n] = (f32x4){0.f, 0.f, 0.f, 0.f};
    bf16x8 At[4][2], B0[2][2], B1[2][2];
    const char* cA = (const char*)g.A + (size_t)cur.pm * tstep; const char* cB = (const char*)g.Bt + (size_t)cur.pn * tstep;
    S.a_ready(cur);
    if constexpr (SP2) {
        PG8_STAGE(PG8_SB(0, 0), cB, voffB); PG8_STAGE(PG8_SB(0, 1), cB + hstep, voffB); PG8_STAGE(PG8_SA(0, 0), cA, voffA); PG8_STAGE(PG8_SA(0, 1), cA + hstep, voffA);
        if (wr == 1) PG8_BAR;
        PG8_WAIT_V(2); PG8_BAR;
        PG8_STAGE(PG8_SB(1, 0), cB + kstep, voffB); PG8_STAGE(PG8_SA(1, 0), cA + kstep, voffA); PG8_STAGE(PG8_SB(1, 1), cB + hstep + kstep, voffB);
        PG8_WAIT_V(6); PG8_BAR;
    } else {
        PG8_STAGE(PG8_SB(0, 0), cB, voffB); PG8_STAGE(PG8_SA(0, 0), cA, voffA); PG8_STAGE(PG8_SB(0, 1), cB + hstep, voffB); PG8_STAGE(PG8_SA(0, 1), cA + hstep, voffA);
        if (wr == 1) PG8_BAR;
        PG8_WAIT_V(4); PG8_BAR;
        PG8_STAGE(PG8_SB(1, 0), cB + kstep, voffB); PG8_STAGE(PG8_SA(1, 0), cA + kstep, voffA); PG8_STAGE(PG8_SB(1, 1), cB + hstep + kstep, voffB);
        PG8_WAIT_V(6); PG8_BAR;
    }
    for (;;) {
        const bool has_next = S.next(ui + 1, nxt);
        const char* nA = has_next ? (const char*)g.A + (size_t)nxt.pm * tstep : cA; const char* nB = has_next ? (const char*)g.Bt + (size_t)nxt.pn * tstep : cB;
        for (int t = 0; t < nt; t += 2) {
            const bool last = (t == nt - 2);
            const char* a1 = cA + (size_t)(t + 1) * kstep;
            const char* a2 = last ? nA : cA + (size_t)(t + 2) * kstep; const char* b2 = last ? nB : cB + (size_t)(t + 2) * kstep;
            const char* a3 = a2 + kstep; const char* b3 = b2 + kstep;
            if (last && has_next) S.a_ready(nxt);
            if constexpr (SP2) {
            PG8_LDB(B0, 0, 0); PG8_LDB(B1, 0, 1); PG8_SCHED; PG8_LDA(At, 0, 0); PG8_STAGE(PG8_SA(1, 1), a1 + hstep, voffA);
            PG8_WAIT_V(8); PG8_WAIT_L(0); PG8_BAR; PG8_MMA(0, 0, At, B0); PG8_MMA(0, 1, At, B1); PG8_BAR; PG8_SCHED;
            PG8_LDA(At, 0, 1); PG8_STAGE(PG8_SB(0, 0), b2, voffB); PG8_STAGE(PG8_SB(0, 1), b2 + hstep, voffB); PG8_STAGE(PG8_SA(0, 0), a2, voffA);
            PG8_WAIT_V(8); PG8_WAIT_L(0); PG8_BAR; PG8_MMA(1, 0, At, B0); PG8_MMA(1, 1, At, B1); PG8_BAR; PG8_SCHED;
            PG8_LDB(B0, 1, 0); PG8_LDB(B1, 1, 1); PG8_SCHED; PG8_LDA(At, 1, 0); PG8_STAGE(PG8_SA(0, 1), a2 + hstep, voffA);
            PG8_WAIT_V(8); PG8_WAIT_L(0); PG8_BAR; PG8_MMA(0, 0, At, B0); PG8_MMA(0, 1, At, B1); PG8_BAR; PG8_SCHED;
            PG8_LDA(At, 1, 1); PG8_STAGE(PG8_SB(1, 0), b3, voffB); PG8_STAGE(PG8_SB(1, 1), b3 + hstep, voffB); PG8_STAGE(PG8_SA(1, 0), a3, voffA);
            PG8_WAIT_V(8); PG8_WAIT_L(0); PG8_BAR; PG8_MMA(1, 0, At, B0); PG8_MMA(1, 1, At, B1); PG8_BAR; PG8_SCHED;
            } else {
            PG8_LDB(B0, 0, 0); PG8_SCHED; PG8_LDA(At, 0, 0); PG8_STAGE(PG8_SA(1, 1), a1 + hstep, voffA);
            PG8_WAIT_L(8); PG8_BAR; PG8_WAIT_L(0); PG8_MMA(0, 0, At, B0); PG8_BAR; PG8_SCHED;
            PG8_LDB(B1, 0, 1); PG8_STAGE(PG8_SB(0, 0), b2, voffB);
            PG8_BAR; PG8_WAIT_L(0); PG8_MMA(0, 1, At, B1); PG8_BAR;
            PG8_LDA(At, 0, 1); PG8_STAGE(PG8_SA(0, 0), a2, voffA);
            PG8_BAR; PG8_WAIT_L(0); PG8_MMA(1, 0, At, B0); PG8_BAR; PG8_SCHED;
            PG8_STAGE(PG8_SB(0, 1), b2 + hstep, voffB);
            PG8_WAIT_V(6); PG8_BAR; PG8_MMA(1, 1, At, B1); PG8_BAR;
            PG8_LDB(B0, 1, 0); PG8_SCHED; PG8_LDA(At, 1, 0); PG8_STAGE(PG8_SA(0, 1), a2 + hstep, voffA);
            PG8_WAIT_L(8); PG8_BAR; PG8_WAIT_L(0); PG8_MMA(0, 0, At, B0); PG8_BAR; PG8_SCHED;
            PG8_LDB(B1, 1, 1); PG8_STAGE(PG8_SB(1, 0), b3, voffB);
            PG8_BAR; PG8_WAIT_L(0); PG8_MMA(0, 1, At, B1); PG8_BAR;
            PG8_LDA(At, 1, 1); PG8_STAGE(PG8_SA(1, 0), a3, voffA);
            PG8_BAR; PG8_WAIT_L(0); PG8_MMA(1, 0, At, B0); PG8_BAR; PG8_SCHED;
            PG8_STAGE(PG8_SB(1, 1), b3 + hstep, voffB);
            PG8_WAIT_V(6); PG8_BAR; PG8_MMA(1, 1, At, B1); PG8_BAR;
            }
        }
        if constexpr (ALIGN_EPI) { if (wr == 0) PG8_BAR; }
        if constexpr (!Epi::AFTER_DRAIN) { E(acc, cur, wr, wc, fr, fq); S.done(cur); }
        if (!has_next) break;
#pragma unroll
        for (int a = 0; a < 2; ++a)
#pragma unroll
            for (int b = 0; b < 2; ++b)
#pragma unroll
                for (int m = 0; m < 4; ++m)
#pragma unroll
                    for (int n = 0; n < 2; ++n) acc[a][b][m][n] = (f32x4){0.f, 0.f, 0.f, 0.f};
        cur = nxt; cA = nA; cB = nB; ++ui;
        if constexpr (ALIGN_EPI) { if (wr == 1) PG8_BAR; }
    }
    PG8_WAIT_V(0);
    if constexpr (!ALIGN_EPI) { if (wr == 0) PG8_BAR; }
    PG8_BAR;
    if constexpr (Epi::AFTER_DRAIN) { E.fused(acc, cur, wr, wc, fr, fq, lds, wid, lane); S.done(cur); }
#undef PG8_SA
#undef PG8_SB
#undef PG8_STAGE
#undef PG8_LDA
#undef PG8_LDB
#undef PG8_MMA
#undef PG8_WAIT_V
#undef PG8_WAIT_L
#undef PG8_BAR
#undef PG8_SCHED
}
}

#define PG8_SP2 true
#define PG8_ALIGN true

namespace att {
using bf16 = __hip_bfloat16;
constexpr int   D = 128, NW = 8, QBLK = 32, KVBLK = 64;
constexpr float SCALE = 0.088388347648318440f, LOG2E = 1.4426950408889634f, CS = SCALE * LOG2E;
constexpr float THR2 = 8.f * LOG2E;
constexpr int LDQ = 8704, LDK = 8704;
constexpr size_t SHM_V = KVBLK * D * 2, SHM_K = KVBLK * D * 2, SHM_ATTN = 2 * SHM_V + 2 * SHM_K + NW * 64 * 4;
using bf16x8 = __attribute__((ext_vector_type(8))) short;
using s16x4  = __attribute__((ext_vector_type(4))) short;
using f32x16 = __attribute__((ext_vector_type(16))) float;
using u32x4  = __attribute__((ext_vector_type(4))) unsigned;
#define KSWZ(row, colB) ((row) * 256 + ((colB) ^ (((row) & 7) << 4)))
#define SBAR() __builtin_amdgcn_sched_barrier(0)
__device__ __forceinline__ int crow(int r, int hi) { return (r & 3) + 8 * (r >> 2) + 4 * hi; }
__device__ __forceinline__ unsigned cvtpk(float lo, float hi) {
  unsigned r; asm volatile("v_cvt_pk_bf16_f32 %0, %1, %2" : "=v"(r) : "v"(lo), "v"(hi)); return r;
}
#ifndef ATT_BIAS_INIT
#define ATT_BIAS_INIT 0
#endif
#ifndef ATT_SDEPTH
#define ATT_SDEPTH 1
#endif
template <bool WIN>
__device__ __forceinline__ void partialSM(f32x16& p0, f32x16& p1, float& m_reg, float& mn, float& alpha, float dqh, float nsl) {
#if !ATT_BIAS_INIT
#pragma unroll
  for (int r = 0; r < 16; ++r) { const float d = fabsf(dqh - (float)((r & 3) + 8 * (r >> 2))); float t = fmaf(d, nsl, p0[r]); if (WIN) t = d <= 128.f ? t : -1e30f; p0[r] = t; }
#pragma unroll
  for (int r = 0; r < 16; ++r) { const float d = fabsf(dqh - (float)(32 + (r & 3) + 8 * (r >> 2))); float t = fmaf(d, nsl, p1[r]); if (WIN) t = d <= 128.f ? t : -1e30f; p1[r] = t; }
#endif
  float pmax = p0[0];
#pragma unroll
  for (int r = 1; r < 16; ++r) pmax = fmaxf(pmax, p0[r]);
#pragma unroll
  for (int r = 0; r < 16; ++r) pmax = fmaxf(pmax, p1[r]);
  { auto rr = __builtin_amdgcn_permlane32_swap(__float_as_uint(pmax), __float_as_uint(pmax), false, false);
    pmax = fmaxf(__uint_as_float(rr[0]), __uint_as_float(rr[1])); }
  if (__builtin_expect(__all(pmax - m_reg <= THR2), 1)) { mn = m_reg; alpha = 1.f; }
  else { mn = fmaxf(m_reg, pmax); alpha = __builtin_amdgcn_exp2f(m_reg - mn); m_reg = mn; }
#pragma unroll
  for (int r = 0; r < 16; ++r) p0[r] -= mn;
#pragma unroll
  for (int r = 0; r < 16; ++r) p1[r] -= mn;
#pragma unroll
  for (int r = 0; r < 16; ++r) p0[r] = __builtin_amdgcn_exp2f(p0[r]);
}
__device__ __forceinline__ void finishSM(f32x16& p0, f32x16& p1, float alpha, float& l_reg, bf16x8& pa0, bf16x8& pa1, bf16x8& pa2, bf16x8& pa3) {
#pragma unroll
  for (int r = 0; r < 16; ++r) p1[r] = __builtin_amdgcn_exp2f(p1[r]);
  float ps = 0;
#pragma unroll
  for (int r = 0; r < 16; ++r) ps += p0[r];
#pragma unroll
  for (int r = 0; r < 16; ++r) ps += p1[r];
  { auto rr = __builtin_amdgcn_permlane32_swap(__float_as_uint(ps), __float_as_uint(ps), false, false);
    ps = __uint_as_float(rr[0]) + __uint_as_float(rr[1]); }
  l_reg = l_reg * alpha + ps;
#define PK4(P, BASE, OUT) do { unsigned a0 = cvtpk(P[BASE + 0], P[BASE + 1]), a1 = cvtpk(P[BASE + 2], P[BASE + 3]);   \
    unsigned b0 = cvtpk(P[BASE + 4], P[BASE + 5]), b1 = cvtpk(P[BASE + 6], P[BASE + 7]);                              \
    auto r0 = __builtin_amdgcn_permlane32_swap(a0, b0, false, false); auto r1 = __builtin_amdgcn_permlane32_swap(a1, b1, false, false); \
    u32x4 w = {r0[0], r1[0], r0[1], r1[1]}; OUT = *reinterpret_cast<bf16x8*>(&w); } while (0)
  PK4(p0, 0, pa0); PK4(p0, 8, pa1); PK4(p1, 0, pa2); PK4(p1, 8, pa3);
#undef PK4
}
template <bool WIN>
__device__ __forceinline__ void qkt(f32x16& p0, f32x16& p1, const bf16* Ks, const bf16x8* qr, int r32, int hi, float dqh, float nsl) {
#if ATT_BIAS_INIT
#pragma unroll
  for (int r = 0; r < 16; ++r) { const float d = fabsf(dqh - (float)((r & 3) + 8 * (r >> 2))); float b = nsl * d; if (WIN) b = d <= 128.f ? b : -1e30f; p0[r] = b; }
#pragma unroll
  for (int r = 0; r < 16; ++r) { const float d = fabsf(dqh - (float)(32 + (r & 3) + 8 * (r >> 2))); float b = nsl * d; if (WIN) b = d <= 128.f ? b : -1e30f; p1[r] = b; }
#else
  p0 = f32x16{}; p1 = f32x16{};
#endif
#pragma unroll
  for (int d0 = 0; d0 < 8; ++d0) { int cb = (d0 * 16 + hi * 8) * 2;
    bf16x8 b0 = *reinterpret_cast<const bf16x8*>((const char*)Ks + KSWZ(r32, cb));
    bf16x8 b1 = *reinterpret_cast<const bf16x8*>((const char*)Ks + KSWZ(32 + r32, cb));
    p0 = __builtin_amdgcn_mfma_f32_32x32x16_bf16(b0, qr[d0], p0, 0, 0, 0);
    p1 = __builtin_amdgcn_mfma_f32_32x32x16_bf16(b1, qr[d0], p1, 0, 0, 0); }
}
__device__ __forceinline__ int v_st(int k, int c) { const int kk = (k & ~0xC) | ((k & 4) << 1) | ((k & 8) >> 1); return ((kk >> 3) * 4 + (c >> 5)) * 512 + ((kk & 7) * 32 + (c & 31)) * 2; }
__device__ __forceinline__ int v_rd_base(int lane) { return ((lane & 3) << 3) | (((lane >> 2) & 3) << 6) | (((lane >> 4) & 1) << 5) | (((lane >> 5) & 1) << 8); }
constexpr int v_rd_off(int d0, int ks, int half) { return d0 * 512 + ks * 4096 + half * 2048; }
template <int OFF> __device__ __forceinline__ s16x4 tr_read(int vb) {
  s16x4 r; asm volatile("ds_read_b64_tr_b16 %0, %1 offset:%2" : "=&v"(r) : "v"(vb), "i"(OFF) : "memory"); return r;
}
template <int D0> __device__ __forceinline__ void pv_one(f32x16& od, int vb, bf16x8 pa0, bf16x8 pa1, bf16x8 pa2, bf16x8 pa3) {
  const s16x4 l0 = tr_read<v_rd_off(D0, 0, 0)>(vb), h0 = tr_read<v_rd_off(D0, 0, 1)>(vb), l1 = tr_read<v_rd_off(D0, 1, 0)>(vb), h1 = tr_read<v_rd_off(D0, 1, 1)>(vb);
  const s16x4 l2 = tr_read<v_rd_off(D0, 2, 0)>(vb), h2 = tr_read<v_rd_off(D0, 2, 1)>(vb), l3 = tr_read<v_rd_off(D0, 3, 0)>(vb), h3 = tr_read<v_rd_off(D0, 3, 1)>(vb);
  asm volatile("s_waitcnt lgkmcnt(0)" ::: "memory"); SBAR();
#define PK(L, H) (bf16x8){L[0], L[1], L[2], L[3], H[0], H[1], H[2], H[3]}
  od = __builtin_amdgcn_mfma_f32_32x32x16_bf16(pa0, PK(l0, h0), od, 0, 0, 0);
  od = __builtin_amdgcn_mfma_f32_32x32x16_bf16(pa1, PK(l1, h1), od, 0, 0, 0);
  od = __builtin_amdgcn_mfma_f32_32x32x16_bf16(pa2, PK(l2, h2), od, 0, 0, 0);
  od = __builtin_amdgcn_mfma_f32_32x32x16_bf16(pa3, PK(l3, h3), od, 0, 0, 0);
#undef PK
}
__device__ __forceinline__ void pv_d0(f32x16* o, int vb, bf16x8 pa0, bf16x8 pa1, bf16x8 pa2, bf16x8 pa3) {
  pv_one<0>(o[0], vb, pa0, pa1, pa2, pa3); pv_one<1>(o[1], vb, pa0, pa1, pa2, pa3); pv_one<2>(o[2], vb, pa0, pa1, pa2, pa3); pv_one<3>(o[3], vb, pa0, pa1, pa2, pa3);
}

template <bool WIN, bool OUTBF>
__device__ __forceinline__ void attn_body(const bf16* __restrict__ Qb, const bf16* __restrict__ Kh, const bf16* __restrict__ Vh,
                                          void* __restrict__ Ob, int ldo, int seq, char* lds, int dq0, float nsl, float m0, float l0) {
  int tid_ = threadIdx.x; asm volatile("" : "+v"(tid_));
  const int tid = tid_, wid = tid >> 6, lane = tid & 63, r32 = lane & 31, hi = lane >> 5;
  bf16* V_lds = (bf16*)lds; bf16* K_lds = (bf16*)(lds + 2 * SHM_V);
  float* ws = (float*)(lds + 2 * SHM_V + 2 * SHM_K) + wid * 64; float* li_l = ws; float* al_l = ws + 32;
  float m_reg = m0, l_reg = l0; f32x16 o[4] = {}; bf16x8 qr[8];
  const bf16* Qw = Qb + (long)(wid * QBLK + r32) * LDQ + hi * 8;
#pragma unroll
  for (int d0 = 0; d0 < 8; ++d0) qr[d0] = *reinterpret_cast<const bf16x8*>(Qw + d0 * 16);
  const float dql = (float)(dq0 + wid * QBLK + r32 - 4 * hi);
  const int sr = tid >> 4, sc = (tid & 15) * 8, vst0 = v_st(sr, sc), vst1 = v_st(32 + sr, sc);
  const int vb0 = (int)(uintptr_t)V_lds + v_rd_base(lane);
  struct { bf16x8 vs0, vs1, ks0, ks1; } sr_[ATT_SDEPTH];
#define LD8(p) (*reinterpret_cast<const bf16x8*>(p))
#define SLOAD(i, k0) do { sr_[i].vs0 = LD8(&Vh[(long)((k0) + sr) * LDK + sc]); sr_[i].vs1 = LD8(&Vh[(long)((k0) + 32 + sr) * LDK + sc]); \
    sr_[i].ks0 = LD8(&Kh[(long)((k0) + sr) * LDK + sc]); sr_[i].ks1 = LD8(&Kh[(long)((k0) + 32 + sr) * LDK + sc]); } while (0)
#define SWRITE(b, i) do { *(bf16x8*)((char*)V_lds + (b) * SHM_V + vst0) = sr_[i].vs0;          \
    *(bf16x8*)((char*)V_lds + (b) * SHM_V + vst1) = sr_[i].vs1; int kc = sc * 2;               \
    *(bf16x8*)((char*)K_lds + (b) * SHM_K + KSWZ(sr, kc)) = sr_[i].ks0;                       \
    *(bf16x8*)((char*)K_lds + (b) * SHM_K + KSWZ(32 + sr, kc)) = sr_[i].ks1; } while (0)
#define SWAIT() do { if (ATT_SDEPTH == 2) asm volatile("s_waitcnt vmcnt(4)" ::: "memory"); else asm volatile("s_waitcnt vmcnt(0)" ::: "memory"); } while (0)
#define RESC(a) do { if (__any((a) < 1.f)) { if (hi == 0) al_l[r32] = (a); asm volatile("s_waitcnt lgkmcnt(0)" ::: "memory"); \
    _Pragma("unroll") for (int d = 0; d < 4; ++d) _Pragma("unroll") for (int r = 0; r < 16; ++r) o[d][r] *= al_l[crow(r, hi)]; } } while (0)
  f32x16 pA0, pA1, pB0, pB1; float mnA, mnB, alA, alB; bf16x8 pa0, pa1, pa2, pa3; const int NT = seq / KVBLK;
  constexpr int SE = 0, SO = ATT_SDEPTH - 1;
  SLOAD(SE, 0); asm volatile("s_waitcnt vmcnt(0)" ::: "memory"); SWRITE(0, SE); __syncthreads();
  qkt<WIN>(pA0, pA1, K_lds, qr, r32, hi, dql, nsl); partialSM<WIN>(pA0, pA1, m_reg, mnA, alA, dql, nsl);
  SLOAD(SO, KVBLK); if (ATT_SDEPTH == 2) { if (2 < NT) SLOAD(SE, 2 * KVBLK); }
  SWAIT(); SWRITE(1, SO); __syncthreads();
  for (int j = 1; j + 1 < NT; j += 2) {
    SBAR(); qkt<WIN>(pB0, pB1, (bf16*)((char*)K_lds + SHM_K), qr, r32, hi, dql - (float)(j * KVBLK), nsl);
    finishSM(pA0, pA1, alA, l_reg, pa0, pa1, pa2, pa3); SBAR();
    SLOAD(SO, (j + ATT_SDEPTH) * KVBLK); SBAR();
    pv_d0(o, vb0, pa0, pa1, pa2, pa3); partialSM<WIN>(pB0, pB1, m_reg, mnB, alB, dql - (float)(j * KVBLK), nsl);
    __syncthreads(); SWAIT(); SWRITE(0, SE);
    RESC(alB); __syncthreads();
    SBAR(); qkt<WIN>(pA0, pA1, K_lds, qr, r32, hi, dql - (float)((j + 1) * KVBLK), nsl);
    finishSM(pB0, pB1, alB, l_reg, pa0, pa1, pa2, pa3); SBAR();
    if (ATT_SDEPTH == 1 || j + 3 < NT) SLOAD(SE, (j + 1 + ATT_SDEPTH) * KVBLK); SBAR();
    pv_d0(o, vb0 + (int)SHM_V, pa0, pa1, pa2, pa3); partialSM<WIN>(pA0, pA1, m_reg, mnA, alA, dql - (float)((j + 1) * KVBLK), nsl);
    __syncthreads(); SWAIT(); SWRITE(1, SO);
    RESC(alA); __syncthreads();
  }
  SBAR(); qkt<WIN>(pB0, pB1, (bf16*)((char*)K_lds + SHM_K), qr, r32, hi, dql - (float)((NT - 1) * KVBLK), nsl);
  finishSM(pA0, pA1, alA, l_reg, pa0, pa1, pa2, pa3); SBAR();
  pv_d0(o, vb0, pa0, pa1, pa2, pa3); partialSM<WIN>(pB0, pB1, m_reg, mnB, alB, dql - (float)((NT - 1) * KVBLK), nsl);
  __syncthreads(); RESC(alB);
  finishSM(pB0, pB1, alB, l_reg, pa0, pa1, pa2, pa3); SBAR();
  pv_d0(o, vb0 + (int)SHM_V, pa0, pa1, pa2, pa3);
  if (hi == 0) li_l[r32] = l_reg; asm volatile("s_waitcnt lgkmcnt(0)" ::: "memory");
  float rli[16];
#pragma unroll
  for (int r = 0; r < 16; ++r) rli[r] = __builtin_amdgcn_rcpf(li_l[crow(r, hi)]);
  if (OUTBF) { bf16* Ow = (bf16*)Ob + (long)(wid * QBLK) * ldo;
#pragma unroll
    for (int r = 0; r < 16; ++r) { const int orow = crow(r, hi);
#pragma unroll
      for (int d0 = 0; d0 < 4; ++d0) Ow[(long)orow * ldo + d0 * 32 + r32] = __float2bfloat16(o[d0][r] * rli[r]); }
  } else { float* Ow = (float*)Ob + (long)(wid * QBLK) * ldo;
#pragma unroll
    for (int r = 0; r < 16; ++r) { const int orow = crow(r, hi);
#pragma unroll
      for (int d0 = 0; d0 < 4; ++d0) Ow[(long)orow * ldo + d0 * 32 + r32] = o[d0][r] * rli[r]; }
  }
  __syncthreads();
#undef LD8
#undef SLOAD
#undef SWRITE
#undef SWAIT
#undef RESC
}
#undef SBAR
#undef KSWZ
}

#define GAS __attribute__((address_space(1)))
#define LAS __attribute__((address_space(3)))
typedef unsigned short bf16;
typedef unsigned v4u __attribute__((ext_vector_type(4)));
typedef float f32x4 __attribute__((ext_vector_type(4)));
typedef short bf16x8 __attribute__((ext_vector_type(8)));
typedef GAS unsigned gu32;
typedef GAS unsigned long long gu64;
#define RLX_AGENT __ATOMIC_RELAXED, __HIP_MEMORY_SCOPE_AGENT
#define LDS_WAIT() asm volatile("s_waitcnt lgkmcnt(0)" ::: "memory")
#define VM_WAIT() asm volatile("s_waitcnt vmcnt(0)" ::: "memory")
__device__ __forceinline__ unsigned long long rt() { return __builtin_amdgcn_s_memrealtime(); }
__device__ __forceinline__ unsigned f2bf(float f) { unsigned u = __builtin_bit_cast(unsigned, f); return (u + 0x7fffu + ((u >> 16) & 1u)) >> 16; }
__device__ __forceinline__ unsigned pk2(float lo, float hi) { return f2bf(lo) | (f2bf(hi) << 16); }

#define XB_TMO      128
#define XB_XCNT(j)  (256  + 64 * (j))
#define XB_XSUB(j)  (1280 + 64 * (j))
#define XB_XGEN(j)  (2304 + 64 * (j))
#define XB_TOP      3328
#define XB_TOPGEN   3392
#define XCD_BAR_WORDS 3456
#define XB_SPIN_CAP (1u << 18)

__device__ __forceinline__ unsigned xb_ld(unsigned* p)              { return __hip_atomic_load(p, __ATOMIC_RELAXED, __HIP_MEMORY_SCOPE_AGENT); }
__device__ __forceinline__ unsigned xb_add(unsigned* p, unsigned v) { return __hip_atomic_fetch_add(p, v, __ATOMIC_RELAXED, __HIP_MEMORY_SCOPE_AGENT); }
__device__ __forceinline__ unsigned xb_xcc_id() { return (unsigned)__builtin_amdgcn_s_getreg((3 << 11) | 20) & 0xFu; }
#define XB_SPIN(cond, bar) do { unsigned _sp = 0; while (cond) { __builtin_amdgcn_s_sleep(1); \
    if ((++_sp & 255u) == 0u) { if (xb_ld(&(bar)[XB_TMO])) break; if (_sp > XB_SPIN_CAP) { atomicAdd(&(bar)[XB_TMO], 1u); break; } } } } while (0)

struct XcdBarrier {
    unsigned* bar; unsigned x;
    volatile LAS unsigned* st;
};

__device__ __forceinline__ XcdBarrier xcd_barrier_post(unsigned* bar, volatile LAS unsigned* st) {
    XcdBarrier b; b.bar = bar; b.x = xb_xcc_id(); b.st = st;
    if (threadIdx.x == 0) (void)xb_add(&bar[XB_XCNT(b.x)], 1u);
    return b;
}
__device__ __forceinline__ void xcd_barrier_complete(unsigned* bar, unsigned x, unsigned& nloc, unsigned& nx) {
    const unsigned G = gridDim.x * gridDim.y * gridDim.z;
    unsigned sum, cnt, mine, sp = 0u;
    for (;;) {
        sum = 0u; cnt = 0u; mine = 0u;
#pragma unroll
        for (unsigned j = 0; j < 16; ++j) { const unsigned c = xb_ld(&bar[XB_XCNT(j)]); sum += c; cnt += (c > 0u) ? 1u : 0u; mine = (j == x) ? c : mine; }
        if (sum == G) break;
        __builtin_amdgcn_s_sleep(1);
        if ((++sp & 255u) == 0u) { if (xb_ld(&bar[XB_TMO])) break; if (sp > XB_SPIN_CAP) { atomicAdd(&bar[XB_TMO], 1u); break; } }
    }
    nloc = mine > 0u ? mine : 1u; nx = cnt > 0u ? cnt : 1u;
}

__device__ __forceinline__ void xcd_barrier(const XcdBarrier& b) {
    asm volatile("s_waitcnt vmcnt(0)" ::: "memory");
    __syncthreads();
    if (threadIdx.x == 0) {
        unsigned* bar = b.bar;
        __builtin_amdgcn_s_waitcnt(0);
        unsigned nloc = b.st[0], nx = b.st[1];
        if (nloc == 0u) { xcd_barrier_complete(bar, b.x, nloc, nx); b.st[0] = nloc; b.st[1] = nx; }
        const unsigned old = xb_add(&bar[XB_XSUB(b.x)], 1u);
        const unsigned gen = old / nloc;
        if (old + 1u == (gen + 1u) * nloc) {
            __builtin_amdgcn_fence(__ATOMIC_RELEASE, "agent");
            asm volatile("s_waitcnt vmcnt(0)" ::: "memory");
            const unsigned og = xb_add(&bar[XB_TOP], 1u);
            const unsigned tg = og / nx;
            if (og + 1u == (tg + 1u) * nx) xb_add(&bar[XB_TOPGEN], 1u);
            else XB_SPIN(xb_ld(&bar[XB_TOPGEN]) == tg, bar);
            __builtin_amdgcn_fence(__ATOMIC_ACQUIRE, "agent");
            xb_add(&bar[XB_XGEN(b.x)], 1u);
            asm volatile("s_waitcnt vmcnt(0)" ::: "memory");
        } else {
            XB_SPIN(xb_ld(&bar[XB_XGEN(b.x)]) == gen, bar);
            __builtin_amdgcn_fence(__ATOMIC_ACQUIRE, "agent");
            asm volatile("s_waitcnt vmcnt(0)" ::: "memory");
        }
    }
    __syncthreads();
}

constexpr int NWAVES = 8;
constexpr int DM = 2048, SEQ = 2048, DEPTH = 4, CSEQ = 8, TC = CSEQ * SEQ, NCHUNK = 3, TPROMPT = 16 * SEQ, TTOT = 24 * SEQ;
constexpr int INC = 8704, DFF = 5504, NEXP = 8, DFE = 1024;
constexpr int ZQA = 0, ZKA = 1024, ZVA = 1280, ZQD = 1536, ZKD = 2560, ZVD = 3584, ZGA = 4608;
constexpr float LN_EPS = 1e-5f, ALPHA = 1.681792830507429f;
constexpr int SLOTS_MAX = 2 * TC + NEXP * 256;
constexpr int NSEG = TC / 64;
constexpr int NPH = 11, NGID = 1 + NCHUNK * DEPTH * NPH;

constexpr size_t MiB = 1u << 20;
constexpr size_t WS_CTL = 0, CTL_ZERO_BYTES = 1 * MiB;
constexpr size_t WS_ROUTE = 1 * MiB, WS_TOKSLOT = WS_ROUTE + (size_t)TC * 16, WS_SLOTGATE = WS_TOKSLOT + (size_t)TC * 8, WS_SEGCNT = WS_SLOTGATE + (size_t)SLOTS_MAX * 4, WS_MOEOFF = WS_SEGCNT + (size_t)NSEG * 8 * 4;
static_assert(WS_MOEOFF + 64 <= 2 * MiB, "small arrays");
constexpr size_t WS_WL = 2 * MiB, WL_STRIDE = 50 * MiB, WL_WIN = 0, WL_WPAD = 34 * MiB, WL_WO = 42 * MiB;
constexpr size_t WS_WD = 202 * MiB, WD_STRIDE = 64 * MiB + MiB / 2, WD_W13 = 0, WD_W2 = 43 * MiB;
constexpr size_t WS_WM = 331 * MiB, WM_STRIDE = 96 * MiB, WM_W13 = 0, WM_W2 = 64 * MiB;
constexpr size_t WS_XB = 524 * MiB, WS_Z = 588 * MiB, WS_U = WS_Z, WS_HBG = WS_Z, WS_UM = WS_Z + 136 * MiB;
constexpr size_t WS_YAD = 860 * MiB, WS_ODIFF = 924 * MiB, WS_OM = 924 * MiB, WS_MERGED = 1052 * MiB, WS_MIX = 1116 * MiB, WS_END = 1180 * MiB;
static_assert((size_t)INC * DM * 2 <= 34 * MiB && (size_t)2 * DFF * DM * 2 <= 43 * MiB && (size_t)DM * DFF * 2 <= WD_STRIDE - WD_W2, "weight map");
static_assert(WS_WD + 2 * WD_STRIDE <= WS_WM && WS_WM + 2 * WM_STRIDE <= WS_XB, "weight map");
static_assert((size_t)TC * INC * 2 <= WS_YAD - WS_Z && (size_t)SLOTS_MAX * DM * 2 <= 136 * MiB && WS_UM + (size_t)SLOTS_MAX * DFE * 2 <= WS_YAD && (size_t)TC * DFF * 2 <= WS_YAD - WS_Z, "z overlays");
static_assert(WS_OM + (size_t)SLOTS_MAX * DM * 2 <= WS_MIX, "om overlay");
constexpr int CW_TMO = 0, CW_BAR = 4096;

constexpr int RING_OFF = 0, RING_BYTES = 131072;
constexpr int LDSCTL_OFF = RING_BYTES, MISC_OFF = LDSCTL_OFF + 320;
constexpr int LDS_BYTES = 147456;

#define GIN(k) ((const float*)(const GAS float*)F.in[k])
struct Frame {
    LAS unsigned char* lds;
    volatile LAS unsigned* MISC;
    gu32* ctl;
    int tid, lane, wave;
    int vcu, G;
    const float* const __attribute__((address_space(4)))* in;
    float* out; unsigned char* ws;
};
__device__ __forceinline__ float wave_sum(float v) {
#pragma unroll
    for (int o = 1; o < 64; o <<= 1) v += __shfl_xor(v, o);
    return v;
}
__device__ __forceinline__ int wave_sum_i(int v) {
#pragma unroll
    for (int o = 1; o < 64; o <<= 1) v += __shfl_xor(v, o);
    return v;
}
__device__ __forceinline__ void relaunder(Frame& F) {
    int t = threadIdx.x; asm volatile("" : "+v"(t)); F.tid = t; F.lane = t & 63; F.wave = __builtin_amdgcn_readfirstlane(t >> 6);
    GAS unsigned char* w = (GAS unsigned char*)F.ws; asm volatile("" : "+s"(w)); F.ws = (unsigned char*)w;
    const float* const __attribute__((address_space(4)))* p = (const float* const __attribute__((address_space(4)))*)__builtin_amdgcn_kernarg_segment_ptr(); asm volatile("" : "+s"(p)); F.in = p;
}
__device__ __forceinline__ void transpose_item(const float* W, int K, int N, bf16* WT, int dst_row, LAS float* scr, int k0, int n0, int lane) {
#pragma unroll 8
    for (int i = 0; i < 32; ++i) { const int kk = 2 * i + (lane >> 5); scr[kk * 33 + (lane & 31)] = W[(size_t)(k0 + kk) * N + n0 + (lane & 31)]; }
    LDS_WAIT(); asm volatile("" ::: "memory");
    const int c = lane & 7;
#pragma unroll
    for (int j = 0; j < 4; ++j) { const int n = (lane >> 3) + 8 * j; const LAS float* s = scr + (8 * c) * 33 + n;
        v4u o; o.x = pk2(s[0 * 33], s[1 * 33]); o.y = pk2(s[2 * 33], s[3 * 33]); o.z = pk2(s[4 * 33], s[5 * 33]); o.w = pk2(s[6 * 33], s[7 * 33]);
        *(GAS v4u*)(WT + (size_t)(dst_row + n) * K + k0 + 8 * c) = o; }
    LDS_WAIT(); asm volatile("" ::: "memory");
}
template <int MODE>
__device__ __forceinline__ void prep_matrix(Frame& F, const float* W, int K, int N, bf16* WT, int row_off, LAS float* scr, int& ibase) {
    const int nblk = N / 32, nitems = (K / 64) * nblk;
    const int gw = F.vcu * NWAVES + F.wave, NGW = F.G * NWAVES;
    const int first = (gw - (ibase % NGW) + NGW) % NGW;
    for (int it = first; it < nitems; it += NGW) { const int kb = it / nblk, nb = it - kb * nblk, n0 = nb * 32;
        const int dst = MODE ? row_off + (n0 >> 7) * 256 + (n0 & 127) : row_off + n0;
        transpose_item(W, K, N, WT, dst, scr, kb * 64, n0, F.lane); }
    ibase += nitems;
}
__device__ __forceinline__ void p0_weights(Frame& F) {
    LAS float* scr = (LAS float*)(F.lds + RING_OFF + F.wave * 16384);
    int ib = 0;
    for (int l = 0; l < DEPTH; ++l) {
        unsigned char* wl = F.ws + WS_WL + (size_t)l * WL_STRIDE;
        prep_matrix<0>(F, GIN(4) + (size_t)l * DM * INC, DM, INC, (bf16*)(wl + WL_WIN), 0, scr, ib);
        prep_matrix<0>(F, GIN(11) + (size_t)l * 1024 * DM, 1024, DM, (bf16*)(wl + WL_WPAD), 0, scr, ib);
        prep_matrix<0>(F, GIN(12) + (size_t)l * 1024 * DM, 1024, DM, (bf16*)(wl + WL_WPAD), 2048, scr, ib);
        prep_matrix<0>(F, GIN(13) + (size_t)l * DM * DM, DM, DM, (bf16*)(wl + WL_WO), 0, scr, ib);
    }
    for (int i = 0; i < 2; ++i) {
        unsigned char* wd = F.ws + WS_WD + (size_t)i * WD_STRIDE;
        prep_matrix<1>(F, GIN(18) + (size_t)i * DM * DFF, DM, DFF, (bf16*)(wd + WD_W13), 0, scr, ib);
        prep_matrix<1>(F, GIN(19) + (size_t)i * DM * DFF, DM, DFF, (bf16*)(wd + WD_W13), 128, scr, ib);
        prep_matrix<0>(F, GIN(20) + (size_t)i * DFF * DM, DFF, DM, (bf16*)(wd + WD_W2), 0, scr, ib);
        unsigned char* wm = F.ws + WS_WM + (size_t)i * WM_STRIDE;
        for (int e = 0; e < NEXP; ++e) {
            prep_matrix<1>(F, GIN(22) + ((size_t)i * NEXP + e) * DM * DFE, DM, DFE, (bf16*)(wm + WM_W13), e * 2048, scr, ib);
            prep_matrix<1>(F, GIN(23) + ((size_t)i * NEXP + e) * DM * DFE, DM, DFE, (bf16*)(wm + WM_W13), e * 2048 + 128, scr, ib);
            prep_matrix<0>(F, GIN(24) + ((size_t)i * NEXP + e) * DFE * DM, DFE, DM, (bf16*)(wm + WM_W2), e * 2048, scr, ib);
        }
    }
}
template <int MODE>
__device__ __forceinline__ void ln_phase(Frame& F, int chunk, const float* gsrc, const float* bsrc, bool moe, const float* router, bool write_bf) {
    f32x4 gv[8], bv[8];
#pragma unroll
    for (int j = 0; j < 8; ++j) { gv[j] = *(const f32x4*)(gsrc + 4 * F.lane + 256 * j); bv[j] = *(const f32x4*)(bsrc + 4 * F.lane + 256 * j); }
    LAS float* rt = (LAS float*)(F.lds);
    LAS int* wcnt = (LAS int*)(F.lds + 65536);
    if (MODE == 1 && moe) {
        for (int idx = F.tid; idx < DM * NEXP; idx += NWAVES * 64) rt[(idx & 7) * DM + (idx >> 3)] = router[idx];
        __syncthreads();
    }
    bf16* XB = (bf16*)(F.ws + WS_XB);
    const bf16* MIX = (const bf16*)(F.ws + WS_MIX);
    const bf16* OM = (const bf16*)(F.ws + WS_OM);
    for (int seg = F.vcu; seg < NSEG; seg += F.G) {
        int cnt[8];
#pragma unroll
        for (int e = 0; e < 8; ++e) cnt[e] = 0;
        for (int i = 0; i < 8; ++i) {
            const int row = seg * 64 + F.wave * 8 + i; const size_t grow = (size_t)chunk * TC + row;
            f32x4 v[8];
            if (MODE == 0) {
                const float* src = grow < (size_t)TPROMPT ? GIN(0) + grow * DM : GIN(1) + (grow - TPROMPT) * DM;
#pragma unroll
                for (int j = 0; j < 8; ++j) v[j] = *(const f32x4*)(src + 4 * F.lane + 256 * j);
            } else {
                const float* src = F.out + grow * DM;
#pragma unroll
                for (int j = 0; j < 8; ++j) v[j] = *(const f32x4*)(src + 4 * F.lane + 256 * j) * ALPHA;
                if (MODE == 1 || MODE == 2) {
                    const bf16* m = MIX + (size_t)row * DM;
#pragma unroll
                    for (int j = 0; j < 8; ++j) { const uint2 w = *(const uint2*)(m + 4 * F.lane + 256 * j);
                        v[j][0] += pg8::bf_lo(w.x); v[j][1] += pg8::bf_hi(w.x); v[j][2] += pg8::bf_lo(w.y); v[j][3] += pg8::bf_hi(w.y); }
                } else {
                    const int2 ts = *(const int2*)(F.ws + WS_TOKSLOT + (size_t)row * 8);
                    const bf16* m1 = OM + (size_t)ts.x * DM; const bf16* m2 = OM + (size_t)ts.y * DM;
#pragma unroll
                    for (int j = 0; j < 8; ++j) { const uint2 w = *(const uint2*)(m1 + 4 * F.lane + 256 * j); const uint2 w2 = *(const uint2*)(m2 + 4 * F.lane + 256 * j);
                        v[j][0] += pg8::bf_lo(w.x) + pg8::bf_lo(w2.x); v[j][1] += pg8::bf_hi(w.x) + pg8::bf_hi(w2.x); v[j][2] += pg8::bf_lo(w.y) + pg8::bf_lo(w2.y); v[j][3] += pg8::bf_hi(w.y) + pg8::bf_hi(w2.y); }
                }
            }
            float s = 0.f;
#pragma unroll
            for (int j = 0; j < 8; ++j) s += (v[j][0] + v[j][1]) + (v[j][2] + v[j][3]);
            const float mean = wave_sum(s) * (1.f / DM); float s2 = 0.f;
#pragma unroll
            for (int j = 0; j < 8; ++j) { v[j] = v[j] - mean; s2 += (v[j][0] * v[j][0] + v[j][1] * v[j][1]) + (v[j][2] * v[j][2] + v[j][3] * v[j][3]); }
            const float rstd = 1.f / sqrtf(wave_sum(s2) * (1.f / DM) + LN_EPS);
#pragma unroll
            for (int j = 0; j < 8; ++j) v[j] = v[j] * rstd * gv[j] + bv[j];
            float* dst = F.out + grow * DM;
#pragma unroll
            for (int j = 0; j < 8; ++j) *(f32x4*)(dst + 4 * F.lane + 256 * j) = v[j];
            if (write_bf) { bf16* xb = XB + (size_t)row * DM;
#pragma unroll
                for (int j = 0; j < 8; ++j) { uint2 w; w.x = pg8::cvt_pk_bf16(v[j][0], v[j][1]); w.y = pg8::cvt_pk_bf16(v[j][2], v[j][3]); *(uint2*)(xb + 4 * F.lane + 256 * j) = w; } }
            if (MODE == 1 && moe) {
                float lg[8];
#pragma unroll
                for (int e = 0; e < 8; ++e) { float a = 0.f;
#pragma unroll
                    for (int j = 0; j < 8; ++j) { const f32x4 w = *(const LAS f32x4*)(rt + e * DM + 4 * F.lane + 256 * j); a += (v[j][0] * w[0] + v[j][1] * w[1]) + (v[j][2] * w[2] + v[j][3] * w[3]); }
                    lg[e] = wave_sum(a); }
                float v1 = -INFINITY; int e1 = 0;
#pragma unroll
                for (int e = 0; e < 8; ++e) if (lg[e] > v1) { v1 = lg[e]; e1 = e; }
                float v2 = -INFINITY; int e2 = 0;
#pragma unroll
                for (int e = 0; e < 8; ++e) if (e != e1 && lg[e] > v2) { v2 = lg[e]; e2 = e; }
                const float g1 = 1.f / (1.f + expf(v2 - v1)), g2 = 1.f - g1;
#pragma unroll
                for (int e = 0; e < 8; ++e) cnt[e] += (e == e1) + (e == e2);
                if (F.lane == 0) { int4 r; r.x = e1; r.y = e2; r.z = __float_as_int(g1); r.w = __float_as_int(g2); *(int4*)(F.ws + WS_ROUTE + (size_t)row * 16) = r; }
            }
        }
        if (MODE == 1 && moe) {
            if (F.lane == 0) {
#pragma unroll
                for (int e = 0; e < 8; ++e) wcnt[F.wave * 8 + e] = cnt[e]; }
            __syncthreads();
            if (F.tid < 8) { int t = 0;
#pragma unroll
                for (int w = 0; w < 8; ++w) t += wcnt[w * 8 + F.tid];
                *(int*)(F.ws + WS_SEGCNT + ((size_t)seg * 8 + F.tid) * 4) = t; }
            __syncthreads();
        }
    }
}
__device__ __forceinline__ void moe_assign_phase(Frame& F) {
    LAS int* sc = (LAS int*)(F.lds);
    LAS int* tot = sc + NSEG * 8; LAS int* pre = tot + 8; LAS int* off = pre + 8; LAS int* e1s = off + 16; LAS int* e2s = e1s + 64; LAS int* sl1 = e2s + 64; LAS int* sl2 = sl1 + 64;
    const bf16* XB = (const bf16*)(F.ws + WS_XB); bf16* HBG = (bf16*)(F.ws + WS_HBG);
    for (int seg = F.vcu; seg < NSEG; seg += F.G) {
        for (int idx = F.tid; idx < NSEG * 8; idx += NWAVES * 64) sc[idx] = *(const int*)(F.ws + WS_SEGCNT + (size_t)idx * 4);
        int4 r = {0, 0, 0, 0};
        if (F.tid < 64) { r = *(const int4*)(F.ws + WS_ROUTE + (size_t)(seg * 64 + F.tid) * 16); e1s[F.tid] = r.x; e2s[F.tid] = r.y; }
        __syncthreads();
        { const int e = F.wave; int t = 0, p = 0;
#pragma unroll
          for (int i = 0; i < NSEG / 64; ++i) { const int s2 = F.lane * (NSEG / 64) + i; const int c = sc[s2 * 8 + e]; t += c; p += (s2 < seg) ? c : 0; }
          t = wave_sum_i(t); p = wave_sum_i(p); if (F.lane == 0) { tot[e] = t; pre[e] = p; } }
        __syncthreads();
        if (F.tid == 0) { int o = 0;
            for (int e = 0; e < 8; ++e) { off[e] = o; o += (tot[e] + 255) & ~255; }
            off[8] = o;
            if (seg == 0) { for (int e = 0; e <= 8; ++e) *(int*)(F.ws + WS_MOEOFF + e * 4) = off[e]; } }
        __syncthreads();
        if (F.tid < 64) { const int e1 = r.x, e2 = r.y; int r1 = 0, r2 = 0;
            for (int t2 = 0; t2 < F.tid; ++t2) { const int a = e1s[t2], b = e2s[t2]; r1 += (a == e1) + (b == e1); r2 += (a == e2) + (b == e2); }
            const int s1 = off[e1] + pre[e1] + r1, s2 = off[e2] + pre[e2] + r2;
            int2 ts; ts.x = s1; ts.y = s2; *(int2*)(F.ws + WS_TOKSLOT + (size_t)(seg * 64 + F.tid) * 8) = ts;
            *(int*)(F.ws + WS_SLOTGATE + (size_t)s1 * 4) = r.z; *(int*)(F.ws + WS_SLOTGATE + (size_t)s2 * 4) = r.w;
            sl1[F.tid] = s1; sl2[F.tid] = s2; }
        __syncthreads();
        for (int q = F.wave * 16; q < F.wave * 16 + 16; ++q) { const int tok = q >> 1; const int slot = (q & 1) ? sl2[tok] : sl1[tok];
            const v4u* src = (const v4u*)(XB + (size_t)(seg * 64 + tok) * DM); v4u* dst = (v4u*)(HBG + (size_t)slot * DM);
#pragma unroll
            for (int i = 0; i < 4; ++i) dst[F.lane + 64 * i] = src[F.lane + 64 * i]; }
        __syncthreads();
    }
}
__device__ __forceinline__ void combine_phase(Frame& F, int l) {
    asm volatile("" : "+s"(l));
    const float* lq1 = GIN(6) + l * 128; const float* lk1 = GIN(7) + l * 128; const float* lq2 = GIN(8) + l * 128; const float* lk2 = GIN(9) + l * 128;
    const float d1 = wave_sum(lq1[F.lane] * lk1[F.lane] + lq1[F.lane + 64] * lk1[F.lane + 64]);
    const float d2 = wave_sum(lq2[F.lane] * lk2[F.lane] + lq2[F.lane + 64] * lk2[F.lane + 64]);
    const float linit = l == 0 ? 0.2f : l == 1 ? 0.35550906759096926f : l == 2 ? 0.4707130183435842f : 0.5560582041556405f;
    const float lam = expf(d1) - expf(d2) + linit;
    const f32x4 g4 = *(const f32x4*)(GIN(10) + l * 256 + 4 * F.lane);
    const float* OD = (const float*)(F.ws + WS_ODIFF); bf16* YD = (bf16*)(F.ws + WS_YAD) + (size_t)TC * 1024;
    const int gw = F.vcu * NWAVES + F.wave, NGW = F.G * NWAVES;
    for (int row = gw; row < TC; row += NGW) {
#pragma unroll
        for (int h = 0; h < 4; ++h) {
            const f32x4 a = *(const f32x4*)(OD + (size_t)row * 2048 + (2 * h) * 256 + 4 * F.lane);
            const f32x4 b = *(const f32x4*)(OD + (size_t)row * 2048 + (2 * h + 1) * 256 + 4 * F.lane);
            const f32x4 d = a - b * lam;
            const float ss = wave_sum((d[0] * d[0] + d[1] * d[1]) + (d[2] * d[2] + d[3] * d[3]));
            const float rs = (1.f / sqrtf(ss * (1.f / 256.f) + LN_EPS)) * (1.f - linit);
            const f32x4 y = d * rs * g4;
            uint2 w; w.x = pg8::cvt_pk_bf16(y[0], y[1]); w.y = pg8::cvt_pk_bf16(y[2], y[3]);
            *(uint2*)(YD + (size_t)row * 1024 + h * 256 + 4 * F.lane) = w;
        }
    }
}
__device__ __forceinline__ void attn_phase(Frame& F, int l, char* lds) {
    asm volatile("" : "+s"(l));
    const att::bf16* Z = (const att::bf16*)(F.ws + WS_Z);
    float* OD = (float*)(F.ws + WS_ODIFF); att::bf16* YA = (att::bf16*)(F.ws + WS_YAD);
    for (int i = 0;; ++i) {
        const int u = i * F.G + F.vcu; if (u >= CSEQ * 4 * 4 * 8) break;
        const int qb = u & 7, cj = (u >> 3) & 3, c = cj >> 1, j = cj & 1, h = (u >> 5) & 3, b = u >> 7;
        const size_t row0 = (size_t)b * SEQ;
        const att::bf16* Q = Z + (row0 + qb * 256) * INC + ZQD + (h * 2 + c) * 128;
        const att::bf16* K = Z + row0 * INC + ZKD + (h * 2 + c) * 128;
        const att::bf16* V = Z + row0 * INC + ZVD + h * 256 + j * 128;
        float* O = OD + (row0 + qb * 256) * 2048 + (h * 2 + c) * 256 + j * 128;
        const float slope = exp2f(-8.0f * (float)(9 + h) / 12.0f);
        att::attn_body<false, false>(Q, K, V, O, 2048, SEQ, lds, qb * 256, -slope * att::LOG2E, -1e30f, 0.f);
    }
    for (int i = 0;; ++i) {
        const int u = i * F.G + F.vcu; if (u >= CSEQ * 8 * 8) break;
        const int qb = u & 7, hq = (u >> 3) & 7, b = u >> 6, g = hq >> 2;
        const size_t row0 = (size_t)b * SEQ;
        const int klo = qb * 256 - 128 < 0 ? 0 : qb * 256 - 128, khi = qb * 256 + 384 > SEQ ? SEQ : qb * 256 + 384;
        const att::bf16* Q = Z + (row0 + qb * 256) * INC + ZQA + hq * 128;
        const att::bf16* K = Z + (row0 + klo) * INC + ZKA + g * 128;
        const att::bf16* V = Z + (row0 + klo) * INC + ZVA + g * 128;
        att::bf16* O = YA + (row0 + qb * 256) * 1024 + hq * 128;
        const float slope = exp2f(-8.0f * (float)(1 + hq) / 12.0f);
        const float sink = GIN(5)[l * 8 + hq];
        att::attn_body<true, true>(Q, K, V, O, 1024, khi - klo, lds, qb * 256 - klo, -slope * att::LOG2E, sink * att::LOG2E, 1.f);
    }
}

struct Args { const float* in[25]; float* out; unsigned char* ws; int lo, hi; };
__global__ void __launch_bounds__(NWAVES * 64, 2) mk_fwd(Args args) {
    extern __shared__ __attribute__((aligned(16))) unsigned char lds[];
    Frame F;
    F.lds = (LAS unsigned char*)lds;
    F.MISC = (volatile LAS unsigned*)(F.lds + MISC_OFF);
    F.tid = threadIdx.x; F.lane = F.tid & 63; F.wave = __builtin_amdgcn_readfirstlane(F.tid >> 6);
    F.G = gridDim.x; { const int bx = blockIdx.x; F.vcu = (F.G % 8 == 0) ? (bx % 8) * (F.G / 8) + bx / 8 : bx; }
    F.in = (const float* const __attribute__((address_space(4)))*)__builtin_amdgcn_kernarg_segment_ptr(); F.out = args.out; F.ws = args.ws;
    F.ctl = (gu32*)(args.ws + WS_CTL);
    for (int u = F.tid; u < (LDS_BYTES - LDSCTL_OFF) / 4; u += NWAVES * 64) ((LAS unsigned*)(F.lds + LDSCTL_OFF))[u] = 0u;
    __syncthreads();
    const int lo = args.lo, hi = args.hi;
    const bool use_bar = (hi - lo) > 1;
    XcdBarrier bar; bar.bar = (unsigned*)(F.ctl + CW_BAR); bar.x = 0; bar.st = nullptr;
    if (use_bar) bar = xcd_barrier_post((unsigned*)(F.ctl + CW_BAR), F.MISC + 8);
#define IN(g) (lo <= (g) && (g) < hi)
#define SEAM(g) do { if ((g) + 1 < hi) xcd_barrier(bar); } while (0)
    typedef pg8::bf16_t pbf;

    if (IN(0)) { relaunder(F); p0_weights(F); SEAM(0); }

    for (int chunk = 0; chunk < NCHUNK; ++chunk)
    for (int l = 0; l < DEPTH; ++l) {
        const int g0 = 1 + (chunk * DEPTH + l) * NPH;
        const bool moe = (l & 1) != 0; const int fi = l >> 1;
        if (l == 0 && IN(g0 + 0)) { relaunder(F); ln_phase<0>(F, chunk, GIN(2), GIN(3), false, nullptr, true); SEAM(g0 + 0); }
        if (IN(g0 + 1)) {
            relaunder(F); unsigned char* ws = F.ws; unsigned char* wl = ws + WS_WL + (size_t)l * WL_STRIDE; unsigned char* wd = ws + WS_WD + (size_t)fi * WD_STRIDE; unsigned char* wm = ws + WS_WM + (size_t)fi * WM_STRIDE; (void)wl; (void)wd; (void)wm;
            pg8::Gemm g{(const pbf*)(ws + WS_XB), (const pbf*)(wl + WL_WIN), TC, INC, DM}; pg8::StaticOrder S; S.init(TC, INC, F.G, (int)blockIdx.x);
            pg8::EpiPlain E{(pbf*)(ws + WS_Z), INC, 0x7fffffff, ZGA / 256, 0x3CFu, att::CS};
            pg8::gemm_phase<pg8::EpiPlain, pg8::StaticOrder, PG8_ALIGN, PG8_SP2>(F.lds + RING_OFF, g, S, E);
            SEAM(g0 + 1);
        }
        if (IN(g0 + 2)) { relaunder(F); attn_phase(F, l, (char*)lds + RING_OFF); SEAM(g0 + 2); }
        if (IN(g0 + 3)) { relaunder(F); combine_phase(F, l); SEAM(g0 + 3); }
        if (IN(g0 + 4)) {
            relaunder(F); unsigned char* ws = F.ws; unsigned char* wl = ws + WS_WL + (size_t)l * WL_STRIDE; unsigned char* wd = ws + WS_WD + (size_t)fi * WD_STRIDE; unsigned char* wm = ws + WS_WM + (size_t)fi * WM_STRIDE; (void)wl; (void)wd; (void)wm;
            pg8::Gemm g{(const pbf*)(ws + WS_YAD), (const pbf*)(wl + WL_WPAD), 2 * TC, 4096, 1024}; pg8::PairOrder S; S.init(TC, F.G, (int)blockIdx.x);
            pg8::EpiGate E{(const pbf*)(ws + WS_Z) + ZGA, INC, (pbf*)(ws + WS_MERGED), DM, TC / 256};
            pg8::gemm_phase<pg8::EpiGate, pg8::PairOrder, PG8_ALIGN, PG8_SP2>(F.lds + RING_OFF, g, S, E);
            SEAM(g0 + 4);
        }
        if (IN(g0 + 5)) {
            relaunder(F); unsigned char* ws = F.ws; unsigned char* wl = ws + WS_WL + (size_t)l * WL_STRIDE; unsigned char* wd = ws + WS_WD + (size_t)fi * WD_STRIDE; unsigned char* wm = ws + WS_WM + (size_t)fi * WM_STRIDE; (void)wl; (void)wd; (void)wm;
            pg8::Gemm g{(const pbf*)(ws + WS_MERGED), (const pbf*)(wl + WL_WO), TC, DM, DM}; pg8::StaticOrder S; S.init(TC, DM, F.G, (int)blockIdx.x);
            pg8::EpiPlain E{(pbf*)(ws + WS_MIX), DM, 0x7fffffff, 0x7fffffff, 0u, 1.0f};
            pg8::gemm_phase<pg8::EpiPlain, pg8::StaticOrder, PG8_ALIGN, PG8_SP2>(F.lds + RING_OFF, g, S, E);
            SEAM(g0 + 5);
        }
        if (IN(g0 + 6)) { relaunder(F); ln_phase<1>(F, chunk, GIN(14) + l * DM, GIN(15) + l * DM, moe, GIN(21) + (size_t)fi * DM * NEXP, true); SEAM(g0 + 6); }
        if (!moe) {
            if (IN(g0 + 8)) {
            relaunder(F); unsigned char* ws = F.ws; unsigned char* wl = ws + WS_WL + (size_t)l * WL_STRIDE; unsigned char* wd = ws + WS_WD + (size_t)fi * WD_STRIDE; unsigned char* wm = ws + WS_WM + (size_t)fi * WM_STRIDE; (void)wl; (void)wd; (void)wm;
                pg8::Gemm g{(const pbf*)(ws + WS_XB), (const pbf*)(wd + WD_W13), TC, 2 * DFF, DM}; pg8::StaticOrder S; S.init(TC, 2 * DFF, F.G, (int)blockIdx.x);
                pg8::EpiSwiGlu E{(pbf*)(ws + WS_U), DFF, 0x7fffffff, nullptr};
                pg8::gemm_phase<pg8::EpiSwiGlu, pg8::StaticOrder, PG8_ALIGN, PG8_SP2>(F.lds + RING_OFF, g, S, E);
                SEAM(g0 + 8);
            }
            if (IN(g0 + 9)) {
            relaunder(F); unsigned char* ws = F.ws; unsigned char* wl = ws + WS_WL + (size_t)l * WL_STRIDE; unsigned char* wd = ws + WS_WD + (size_t)fi * WD_STRIDE; unsigned char* wm = ws + WS_WM + (size_t)fi * WM_STRIDE; (void)wl; (void)wd; (void)wm;
                pg8::Gemm g{(const pbf*)(ws + WS_U), (const pbf*)(wd + WD_W2), TC, DM, DFF}; pg8::StaticOrder S; S.init(TC, DM, F.G, (int)blockIdx.x);
                pg8::EpiPlain E{(pbf*)(ws + WS_MIX), DM, 0x7fffffff, 0x7fffffff, 0u, 1.0f};
                pg8::gemm_phase<pg8::EpiPlain, pg8::StaticOrder, PG8_ALIGN, PG8_SP2>(F.lds + RING_OFF, g, S, E);
                SEAM(g0 + 9);
            }
            if (IN(g0 + 10)) { relaunder(F); ln_phase<2>(F, chunk, GIN(16) + l * DM, GIN(17) + l * DM, false, nullptr, l + 1 < DEPTH); SEAM(g0 + 10); }
        } else {
            if (IN(g0 + 7)) { relaunder(F); moe_assign_phase(F); SEAM(g0 + 7); }
            if (IN(g0 + 8) || IN(g0 + 9)) {
                relaunder(F);
                const int* mo = (const int*)(F.ws + WS_MOEOFF);
                #define RFL(x) __builtin_amdgcn_readfirstlane(x)
                pg8::MoeOrder S; S.po1 = RFL(mo[1] >> 8); S.po2 = RFL(mo[2] >> 8); S.po3 = RFL(mo[3] >> 8); S.po4 = RFL(mo[4] >> 8); S.po5 = RFL(mo[5] >> 8); S.po6 = RFL(mo[6] >> 8); S.po7 = RFL(mo[7] >> 8); S.P = RFL(mo[8] >> 8);
#undef RFL
                S.G = F.G; S.c = F.vcu;
                if (S.P > SLOTS_MAX / 256) S.P = SLOTS_MAX / 256;
                if (IN(g0 + 8)) {
            relaunder(F); unsigned char* ws = F.ws; unsigned char* wl = ws + WS_WL + (size_t)l * WL_STRIDE; unsigned char* wd = ws + WS_WD + (size_t)fi * WD_STRIDE; unsigned char* wm = ws + WS_WM + (size_t)fi * WM_STRIDE; (void)wl; (void)wd; (void)wm;
                    pg8::Gemm g{(const pbf*)(ws + WS_HBG), (const pbf*)(wm + WM_W13), SLOTS_MAX, NEXP * 2048, DM};
                    pg8::EpiSwiGlu E{(pbf*)(ws + WS_UM), DFE, 7, (const float*)(ws + WS_SLOTGATE)};
                    pg8::gemm_phase<pg8::EpiSwiGlu, pg8::MoeOrder, PG8_ALIGN, PG8_SP2>(F.lds + RING_OFF, g, S, E);
                    SEAM(g0 + 8);
                }
                if (IN(g0 + 9)) {
            relaunder(F); unsigned char* ws = F.ws; unsigned char* wl = ws + WS_WL + (size_t)l * WL_STRIDE; unsigned char* wd = ws + WS_WD + (size_t)fi * WD_STRIDE; unsigned char* wm = ws + WS_WM + (size_t)fi * WM_STRIDE; (void)wl; (void)wd; (void)wm;
                    pg8::Gemm g{(const pbf*)(ws + WS_UM), (const pbf*)(wm + WM_W2), SLOTS_MAX, NEXP * 2048, DFE};
                    pg8::EpiPlain E{(pbf*)(ws + WS_OM), DM, 7, 0x7fffffff, 0u, 1.0f};
                    pg8::gemm_phase<pg8::EpiPlain, pg8::MoeOrder, PG8_ALIGN, PG8_SP2>(F.lds + RING_OFF, g, S, E);
                    SEAM(g0 + 9);
                }
            }
            if (IN(g0 + 10)) { relaunder(F); ln_phase<3>(F, chunk, GIN(16) + l * DM, GIN(17) + l * DM, false, nullptr, l + 1 < DEPTH); SEAM(g0 + 10); }
        }
    }
#undef IN
#undef SEAM
}

extern "C" void kernel_launch(void* const* d_in, const int* in_sizes, int n_in, void* d_out, int out_size, void* d_ws, size_t ws_size, hipStream_t stream) {
    static int grid = 0;
    if (grid == 0) {
        if (n_in != 25 || in_sizes[0] != TPROMPT * DM || in_sizes[1] != (TTOT - TPROMPT) * DM || out_size != TTOT * DM || ws_size < WS_END) {
            fprintf(stderr, "kernel_launch: shape/workspace mismatch (n_in %d, ws %zu, need %zu); nothing launched\n", n_in, ws_size, (size_t)WS_END); grid = -1; return; }
        int dev = 0, cus = 0;
        if (hipGetDevice(&dev) != hipSuccess || hipDeviceGetAttribute(&cus, hipDeviceAttributeMultiprocessorCount, dev) != hipSuccess) { grid = -1; return; }
        if (hipFuncSetAttribute((const void*)mk_fwd, hipFuncAttributeMaxDynamicSharedMemorySize, LDS_BYTES) != hipSuccess) { fprintf(stderr, "kernel_launch: hipFuncSetAttribute failed\n"); grid = -1; return; }
        int per_cu = 0;
        if (hipOccupancyMaxActiveBlocksPerMultiprocessor(&per_cu, (const void*)mk_fwd, NWAVES * 64, LDS_BYTES) != hipSuccess || per_cu < 1)
            fprintf(stderr, "kernel_launch: note: occupancy query reports %d workgroups per CU\n", per_cu);
        (void)hipGetLastError();
        grid = cus;
    }
    if (grid < 0) return;
    if (hipMemsetAsync((char*)d_ws + WS_CTL, 0, CTL_ZERO_BYTES, stream) != hipSuccess) return;
    Args a{};
    for (int i = 0; i < 25; ++i) a.in[i] = (const float*)d_in[i];
    a.out = (float*)d_out; a.ws = (unsigned char*)d_ws;
#if MK_PER_PHASE
    for (int g = 0; g < NGID; ++g) {
        if (g > 0) { const int k = (g - 1) % NPH, l = ((g - 1) / NPH) % DEPTH; if (k == 0 && l != 0) continue; if (k == 7 && !(l & 1)) continue; }
        a.lo = g; a.hi = g + 1;
        hipLaunchKernelGGL(mk_fwd, dim3(grid), dim3(NWAVES * 64), LDS_BYTES, stream, a);
    }
#else
    a.lo = 0; a.hi = NGID;
    hipLaunchKernelGGL(mk_fwd, dim3(grid), dim3(NWAVES * 64), LDS_BYTES, stream, a);
#endif
    const hipError_t le = hipPeekAtLastError();
    if (le != hipSuccess) fprintf(stderr, "kernel_launch: launch failed: %s\n", hipGetErrorName(le));
}
```

```cpp
#include <hip/hip_runtime.h>
#include <hip/hip_bf16.h>
#include <cstdio>
#include <cstdint>
#include <cmath>

#ifndef MK_PER_PHASE
#define MK_PER_PHASE 0
#endif

namespace pg8 {
#define PG8_LAS __attribute__((address_space(3)))
typedef unsigned short bf16_t;
typedef short bf16x8 __attribute__((ext_vector_type(8)));
typedef float f32x4 __attribute__((ext_vector_type(4)));
typedef unsigned u32x4 __attribute__((ext_vector_type(4)));
constexpr int BM = 256, BK = 64, HALF = 128, HTB = HALF * BK * 2  , STAGE_BYTES = 8 * HTB, NXCD = 8, WGM = 8;

__host__ __device__ __forceinline__ int lds_byte(int r, int c) { const int st = (r >> 4) * 2 + (c >> 5), rr = r & 15, cc = c & 31, ob = rr * 64 + cc * 2; return st * 1024 + (ob ^ (((ob >> 9) & 1) << 5)); }
__host__ __device__ __forceinline__ void stage_rc(int b, int& R, int& C) { const int st = b / 1024, sb = b % 1024, swz = sb ^ (((sb >> 9) & 1) << 5); R = (st >> 1) * 16 + swz / 64; C = (st & 1) * 32 + (swz % 64) / 2; }
__host__ __device__ __forceinline__ int perm32(int rho) { const int n = rho >> 4, i = rho & 15; return 8 * (i >> 2) + 4 * n + (i & 3); }

struct Unit { int pm, pn; };
struct Gemm { const bf16_t* A; const bf16_t* Bt; int M, N, K; };

struct StaticOrder {
    int nM, nN, nwg, G, c;
    __host__ __device__ void init(int M, int N, int G_, int c_) { nM = M / BM; nN = N / BM; nwg = nM * nN; G = G_; c = c_; }
    __host__ __device__ bool next(int i, Unit& u) const {
        const long L = (long)i * G + c; if (L >= nwg) return false;
        int wgid = (int)L; { const int q = nwg / NXCD, r = nwg % NXCD, xcd = wgid % NXCD, off = wgid / NXCD; wgid = (xcd < r ? xcd * (q + 1) : r * (q + 1) + (xcd - r) * q) + off; }
        const int nig = WGM * nN, gid = wgid / nig, fm = gid * WGM, gsz = (nM - fm) < WGM ? (nM - fm) : WGM;
        u.pm = fm + ((wgid % nig) % gsz); u.pn = (wgid % nig) / gsz; return true;
    }
    __device__ __forceinline__ void a_ready(const Unit&) const {}
    __device__ __forceinline__ void done(const Unit&) const {}
};


__device__ __forceinline__ unsigned cvt_pk_bf16(float lo, float hi) { unsigned r; asm volatile("v_cvt_pk_bf16_f32 %0, %1, %2" : "=v"(r) : "v"(lo), "v"(hi)); return r; }
__device__ __forceinline__ float bf_lo(unsigned w) { return __uint_as_float(w << 16); }
__device__ __forceinline__ float bf_hi(unsigned w) { return __uint_as_float(w & 0xffff0000u); }
__device__ __forceinline__ float sigmoidf_fast(float x) { return __builtin_amdgcn_rcpf(1.0f + __builtin_amdgcn_exp2f(-1.4426950408889634f * x)); }
#ifndef EPI_WT
#define EPI_WT 0
#endif
__device__ __forceinline__ void st16(void* p, u32x4 v) {
#if EPI_WT
    asm volatile("global_store_dwordx4 %0, %1, off sc1" :: "v"(p), "v"(v) : "memory");
#else
    *(u32x4*)p = v;
#endif
}
__device__ __forceinline__ u32x4 pack8(f32x4 v0, f32x4 v1) { u32x4 w; w.x = cvt_pk_bf16(v0[0], v0[1]); w.y = cvt_pk_bf16(v0[2], v0[3]); w.z = cvt_pk_bf16(v1[0], v1[1]); w.w = cvt_pk_bf16(v1[2], v1[3]); return w; }

struct EpiPlain {
    static constexpr bool PERM = true, AFTER_DRAIN = false;
    bf16_t* O; int ldc; int pn_mask; int gate_pn0; unsigned qmask; float qscale; float mul;
    __device__ __forceinline__ void operator()(const f32x4 (&acc)[2][2][4][2], const Unit& u, int wr, int wc, int fr, int fq) const {
        const int row0 = u.pm * BM + wr * 64 + fr; const int col0 = (u.pn & pn_mask) * BM + wc * 32 + 8 * fq; const bool sg = u.pn >= gate_pn0;
        const float sc = ((u.pn < 32 && ((qmask >> u.pn) & 1u)) ? qscale : 1.0f) * mul;
#pragma unroll
        for (int ai = 0; ai < 2; ++ai)
#pragma unroll
            for (int m = 0; m < 4; ++m) { bf16_t* rowp = O + (size_t)(row0 + ai * HALF + m * 16) * ldc + col0;
#pragma unroll
                for (int bj = 0; bj < 2; ++bj) { f32x4 v0 = acc[ai][bj][m][0] * sc, v1 = acc[ai][bj][m][1] * sc;
                    if (sg) {
#pragma unroll
                        for (int k = 0; k < 4; ++k) { v0[k] = sigmoidf_fast(v0[k]); v1[k] = sigmoidf_fast(v1[k]); } }
                    st16(rowp + bj * HALF, pack8(v0, v1)); } }
    }
};
struct EpiGate {
    static constexpr bool PERM = true, AFTER_DRAIN = false;
    const bf16_t* G; int ldg; bf16_t* O; int ldc; int nM;
    __device__ __forceinline__ void operator()(f32x4 (&acc)[2][2][4][2], const Unit& u, int wr, int wc, int fr, int fq) const {
        const int part = u.pn >= 8 ? 1 : 0; const int pm = u.pm - part * nM, pn = u.pn - part * 8;
        const int row0 = pm * BM + wr * 64 + fr; const int col0 = pn * BM + wc * 32 + 8 * fq;
        u32x4 g[2][4][2];
#pragma unroll
        for (int ai = 0; ai < 2; ++ai)
#pragma unroll
            for (int m = 0; m < 4; ++m)
#pragma unroll
                for (int bj = 0; bj < 2; ++bj) g[ai][m][bj] = *(const u32x4*)(G + (size_t)(row0 + ai * HALF + m * 16) * ldg + part * 2048 + col0 + bj * HALF);
        __builtin_amdgcn_sched_barrier(0);
#pragma unroll
        for (int ai = 0; ai < 2; ++ai)
#pragma unroll
            for (int m = 0; m < 4; ++m)
#pragma unroll
                for (int bj = 0; bj < 2; ++bj) { const u32x4 w = g[ai][m][bj]; f32x4& v0 = acc[ai][bj][m][0]; f32x4& v1 = acc[ai][bj][m][1];
                    v0[0] *= bf_lo(w.x); v0[1] *= bf_hi(w.x); v0[2] *= bf_lo(w.y); v0[3] *= bf_hi(w.y);
                    v1[0] *= bf_lo(w.z); v1[1] *= bf_hi(w.z); v1[2] *= bf_lo(w.w); v1[3] *= bf_hi(w.w); }
        if (part) {
#pragma unroll
            for (int ai = 0; ai < 2; ++ai)
#pragma unroll
                for (int m = 0; m < 4; ++m)
#pragma unroll
                    for (int bj = 0; bj < 2; ++bj) g[ai][m][bj] = *(const u32x4*)(O + (size_t)(row0 + ai * HALF + m * 16) * ldc + col0 + bj * HALF);
            __builtin_amdgcn_sched_barrier(0);
#pragma unroll
            for (int ai = 0; ai < 2; ++ai)
#pragma unroll
                for (int m = 0; m < 4; ++m)
#pragma unroll
                    for (int bj = 0; bj < 2; ++bj) { const u32x4 w = g[ai][m][bj]; f32x4& v0 = acc[ai][bj][m][0]; f32x4& v1 = acc[ai][bj][m][1];
                        v0[0] += bf_lo(w.x); v0[1] += bf_hi(w.x); v0[2] += bf_lo(w.y); v0[3] += bf_hi(w.y);
                        v1[0] += bf_lo(w.z); v1[1] += bf_hi(w.z); v1[2] += bf_lo(w.w); v1[3] += bf_hi(w.w); }
        }
#pragma unroll
        for (int ai = 0; ai < 2; ++ai)
#pragma unroll
            for (int m = 0; m < 4; ++m)
#pragma unroll
                for (int bj = 0; bj < 2; ++bj) *(u32x4*)(O + (size_t)(row0 + ai * HALF + m * 16) * ldc + col0 + bj * HALF) = pack8(acc[ai][bj][m][0], acc[ai][bj][m][1]);
    }
};
template <bool OUT8>
struct EpiSwiGlu {
    static constexpr bool PERM = true, AFTER_DRAIN = false;
    bf16_t* O; int ldc; int pn_mask; const float* rowgate; float in_scale; float out_scale;
    __device__ __forceinline__ void operator()(const f32x4 (&acc)[2][2][4][2], const Unit& u, int wr, int wc, int fr, int fq) const {
        const int row0 = u.pm * BM + wr * 64 + fr; const int col0 = (u.pn & pn_mask) * HALF + wc * 32 + 8 * fq;
#pragma unroll
        for (int ai = 0; ai < 2; ++ai)
#pragma unroll
            for (int m = 0; m < 4; ++m) { const size_t row = (size_t)(row0 + ai * HALF + m * 16);
                const float rg = (rowgate ? rowgate[row] : 1.0f) * out_scale;
                f32x4 v0, v1;
#pragma unroll
                for (int k = 0; k < 4; ++k) { const float a0 = acc[ai][0][m][0][k] * in_scale, a1 = acc[ai][0][m][1][k] * in_scale;
                    v0[k] = a0 * sigmoidf_fast(a0) * (acc[ai][1][m][0][k] * in_scale) * rg; v1[k] = a1 * sigmoidf_fast(a1) * (acc[ai][1][m][1][k] * in_scale) * rg; }
                if (OUT8) { unsigned lo = 0, hi = 0;
                    lo = __builtin_amdgcn_cvt_pk_fp8_f32(v0[0], v0[1], lo, false); lo = __builtin_amdgcn_cvt_pk_fp8_f32(v0[2], v0[3], lo, true);
                    hi = __builtin_amdgcn_cvt_pk_fp8_f32(v1[0], v1[1], hi, false); hi = __builtin_amdgcn_cvt_pk_fp8_f32(v1[2], v1[3], hi, true);
                    typedef unsigned u32x2_ __attribute__((ext_vector_type(2)));
                    *(u32x2_*)((unsigned char*)O + row * ldc + col0) = (u32x2_){lo, hi}; }
                else st16(O + row * ldc + col0, pack8(v0, v1)); }
    }
};
struct PairOrder {
    StaticOrder so;
    __device__ void init(int M, int G_, int c_) { so.init(M, 2048, G_, c_); }
    __device__ bool next(int i, Unit& u) const { Unit t; if (!so.next(i >> 1, t)) return false; const int part = i & 1; u.pm = t.pm + part * so.nM; u.pn = t.pn + part * so.nN; return true; }
    __device__ __forceinline__ void a_ready(const Unit&) const {}
    __device__ __forceinline__ void done(const Unit&) const {}
};
struct UnevenOrder {
    StaticOrder so; int n_mine, first, Gs;
    __device__ void init(int M, int N, int G_, int c_, int nfirst, int n_lo, int n_hi) {
        so.init(M, N, 1, 0); Gs = G_; const int heavy = nfirst % G_;
        if (heavy * n_lo + (G_ - heavy) * n_hi == so.nwg) { if (c_ < heavy) { n_mine = n_lo; first = (G_ - heavy) * n_hi + c_ * n_lo; } else { n_mine = n_hi; first = (c_ - heavy) * n_hi; } }
        else { n_mine = (so.nwg - c_ + G_ - 1) / G_; first = -1 - c_; }
    }
    __device__ bool next(int i, Unit& u) const { if (i >= n_mine) return false; return first >= 0 ? so.next(first + i, u) : so.next(i * Gs + (-1 - first), u); }
    __device__ __forceinline__ void a_ready(const Unit&) const {}
    __device__ __forceinline__ void done(const Unit&) const {}
};
struct MoeOrder {
    int po1, po2, po3, po4, po5, po6, po7, P, G, c;
    __device__ bool next(int i, Unit& u) const {
        const int L = i * G + c; if (L >= P * 8) return false;
        const int p = L >> 3, t = L & 7;
        const int e = (p >= po1) + (p >= po2) + (p >= po3) + (p >= po4) + (p >= po5) + (p >= po6) + (p >= po7);
        u.pm = p; u.pn = e * 8 + t; return true;
    }
    __device__ __forceinline__ void a_ready(const Unit&) const {}
    __device__ __forceinline__ void done(const Unit&) const {}
};

typedef int i32x4_ __attribute__((ext_vector_type(4))); typedef int i32x8_ __attribute__((ext_vector_type(8)));
template <class Epi, class Sched, bool ALIGN_EPI = false, bool SP2 = false, bool FP8 = false>
__device__ __forceinline__ void gemm_phase(PG8_LAS unsigned char* lds, const Gemm g, const Sched& S, const Epi& E, int tid_in) {
    int tid_ = tid_in; asm volatile("" : "+v"(tid_));
    const int tid = tid_, wid = __builtin_amdgcn_readfirstlane(tid >> 6), lane = tid & 63, wr = wid >> 2, wc = wid & 3, fr = lane & 15, fq = lane >> 4;
    const int K = g.K, nt = K / BK;
    unsigned voffA[2], voffB[2];
#pragma unroll
    for (int i = 0; i < 2; ++i) { int R, C; stage_rc(tid * 16 + i * 8192, R, C); const int Rb = Epi::PERM ? ((R & ~31) + perm32(R & 31)) : R;
        voffA[i] = (unsigned)(R * K + C) * 2u; voffB[i] = (unsigned)(Rb * K + C) * 2u; }
    const size_t kstep = (size_t)(BK * 2);
    const size_t hstep = (size_t)HALF * K * 2;
    const size_t tstep = 2 * hstep;
    const unsigned ldsw = (unsigned)wid * 1024u;
    const int aoff = lds_byte(wr * 64 + fr, fq * 8), boff = lds_byte(wc * 32 + fr, fq * 8);
#define PG8_SA(b, h) (((b) * 2 + (h)) * HTB)
#define PG8_SB(b, h) ((4 + (b) * 2 + (h)) * HTB)
#define PG8_STAGE(bufoff, gbase, voff) do { _Pragma("unroll") for (int _i = 0; _i < 2; ++_i) \
        __builtin_amdgcn_global_load_lds((const unsigned*)((const char*)(gbase) + (voff)[_i]), (PG8_LAS unsigned*)(lds + (bufoff) + ldsw + _i * 8192), 16, 0, 0); } while (0)
#define PG8_LDA(dst, b, h) do { _Pragma("unroll") for (int m = 0; m < 4; ++m) _Pragma("unroll") for (int k = 0; k < 2; ++k) dst[m][k] = *(const PG8_LAS bf16x8*)(lds + PG8_SA(b, h) + aoff + m * 2048 + k * 1024); } while (0)
#define PG8_LDB(dst, b, h) do { _Pragma("unroll") for (int n = 0; n < 2; ++n) _Pragma("unroll") for (int k = 0; k < 2; ++k) dst[n][k] = *(const PG8_LAS bf16x8*)(lds + PG8_SB(b, h) + boff + n * 2048 + k * 1024); } while (0)
#define PG8_MMA(ai, bj, At, Bt) do { __builtin_amdgcn_s_setprio(1); if constexpr (FP8) { _Pragma("unroll") for (int m = 0; m < 4; ++m) _Pragma("unroll") for (int n = 0; n < 2; ++n) { \
        const i32x8_ b8_ = __builtin_shufflevector(__builtin_bit_cast(i32x4_, Bt[n][0]), __builtin_bit_cast(i32x4_, Bt[n][1]), 0, 1, 2, 3, 4, 5, 6, 7); \
        const i32x8_ a8_ = __builtin_shufflevector(__builtin_bit_cast(i32x4_, At[m][0]), __builtin_bit_cast(i32x4_, At[m][1]), 0, 1, 2, 3, 4, 5, 6, 7); \
        asm volatile("v_mfma_scale_f32_16x16x128_f8f6f4 %0, %1, %2, %0, %3, %3 op_sel_hi:[0,0,0]" : "+v"(acc[ai][bj][m][n]) : "v"(b8_), "v"(a8_), "v"(sc8_)); } } \
      else { _Pragma("unroll") for (int m = 0; m < 4; ++m) _Pragma("unroll") for (int n = 0; n < 2; ++n) _Pragma("unroll") for (int k = 0; k < 2; ++k) \
        acc[ai][bj][m][n] = __builtin_amdgcn_mfma_f32_16x16x32_bf16(Bt[n][k], At[m][k], acc[ai][bj][m][n], 0, 0, 0); } __builtin_amdgcn_s_setprio(0); } while (0)
#define PG8_WAIT_V(n) asm volatile("s_waitcnt vmcnt(" #n ")" ::: "memory")
#define PG8_WAIT_L(n) asm volatile("s_waitcnt lgkmcnt(" #n ")" ::: "memory")
#define PG8_BAR __builtin_amdgcn_s_barrier()
#define PG8_SCHED __builtin_amdgcn_sched_barrier(0)
    Unit cur, nxt; int ui = 0;
    if (!S.next(0, cur)) return;
    f32x4 acc[2][2][4][2];
#pragma unroll
    for (int a = 0; a < 2; ++a)
#pragma unroll
        for (int b = 0; b < 2; ++b)
#pragma unroll
            for (int m = 0; m < 4; ++m)
#pragma unroll
                for (int n = 0; n < 2; ++n) acc[a][b][m][n] = (f32x4){0.f, 0.f, 0.f, 0.f};
    bf16x8 At[4][2], B0[2][2], B1[2][2];
    int sc8_ = 0x7F7F7F7F; asm volatile("" : "+v"(sc8_));
    const char* cA = (const char*)g.A + (size_t)cur.pm * tstep; const char* cB = (const char*)g.Bt + (size_t)cur.pn * tstep;
    S.a_ready(cur);
    if constexpr (SP2) {
        PG8_STAGE(PG8_SB(0, 0), cB, voffB); PG8_STAGE(PG8_SB(0, 1), cB + hstep, voffB); PG8_STAGE(PG8_SA(0, 0), cA, voffA); PG8_STAGE(PG8_SA(0, 1), cA + hstep, voffA);
        if (wr == 1) PG8_BAR;
        PG8_WAIT_V(2); PG8_BAR;
        PG8_STAGE(PG8_SB(1, 0), cB + kstep, voffB); PG8_STAGE(PG8_SA(1, 0), cA + kstep, voffA); PG8_STAGE(PG8_SB(1, 1), cB + hstep + kstep, voffB);
        PG8_WAIT_V(6); PG8_BAR;
    } else {
        PG8_STAGE(PG8_SB(0, 0), cB, voffB); PG8_STAGE(PG8_SA(0, 0), cA, voffA); PG8_STAGE(PG8_SB(0, 1), cB + hstep, voffB); PG8_STAGE(PG8_SA(0, 1), cA + hstep, voffA);
        if (wr == 1) PG8_BAR;
        PG8_WAIT_V(4); PG8_BAR;
        PG8_STAGE(PG8_SB(1, 0), cB + kstep, voffB); PG8_STAGE(PG8_SA(1, 0), cA + kstep, voffA); PG8_STAGE(PG8_SB(1, 1), cB + hstep + kstep, voffB);
        PG8_WAIT_V(6); PG8_BAR;
    }
    for (;;) {
        const bool has_next = S.next(ui + 1, nxt);
        const char* nA = has_next ? (const char*)g.A + (size_t)nxt.pm * tstep : cA; const char* nB = has_next ? (const char*)g.Bt + (size_t)nxt.pn * tstep : cB;
        for (int t = 0; t < nt; t += 2) {
            const bool last = (t == nt - 2);
            const char* a1 = cA + (size_t)(t + 1) * kstep;
            const char* a2 = last ? nA : cA + (size_t)(t + 2) * kstep; const char* b2 = last ? nB : cB + (size_t)(t + 2) * kstep;
            const char* a3 = a2 + kstep; const char* b3 = b2 + kstep;
            if (last && has_next) S.a_ready(nxt);
            if constexpr (SP2) {
            PG8_LDB(B0, 0, 0); PG8_LDB(B1, 0, 1); PG8_SCHED; PG8_LDA(At, 0, 0); PG8_STAGE(PG8_SA(1, 1), a1 + hstep, voffA);
            PG8_WAIT_V(8); PG8_WAIT_L(0); PG8_BAR; PG8_MMA(0, 0, At, B0); PG8_MMA(0, 1, At, B1); PG8_BAR; PG8_SCHED;
            PG8_LDA(At, 0, 1); PG8_STAGE(PG8_SB(0, 0), b2, voffB); PG8_STAGE(PG8_SB(0, 1), b2 + hstep, voffB); PG8_STAGE(PG8_SA(0, 0), a2, voffA);
            PG8_WAIT_V(8); PG8_WAIT_L(0); PG8_BAR; PG8_MMA(1, 0, At, B0); PG8_MMA(1, 1, At, B1); PG8_BAR; PG8_SCHED;
            PG8_LDB(B0, 1, 0); PG8_LDB(B1, 1, 1); PG8_SCHED; PG8_LDA(At, 1, 0); PG8_STAGE(PG8_SA(0, 1), a2 + hstep, voffA);
            PG8_WAIT_V(8); PG8_WAIT_L(0); PG8_BAR; PG8_MMA(0, 0, At, B0); PG8_MMA(0, 1, At, B1); PG8_BAR; PG8_SCHED;
            PG8_LDA(At, 1, 1); PG8_STAGE(PG8_SB(1, 0), b3, voffB); PG8_STAGE(PG8_SB(1, 1), b3 + hstep, voffB); PG8_STAGE(PG8_SA(1, 0), a3, voffA);
            PG8_WAIT_V(8); PG8_WAIT_L(0); PG8_BAR; PG8_MMA(1, 0, At, B0); PG8_MMA(1, 1, At, B1); PG8_BAR; PG8_SCHED;
            } else {
            PG8_LDB(B0, 0, 0); PG8_SCHED; PG8_LDA(At, 0, 0); PG8_STAGE(PG8_SA(1, 1), a1 + hstep, voffA);
            PG8_WAIT_L(8); PG8_BAR; PG8_WAIT_L(0); PG8_MMA(0, 0, At, B0); PG8_BAR; PG8_SCHED;
            PG8_LDB(B1, 0, 1); PG8_STAGE(PG8_SB(0, 0), b2, voffB);
            PG8_BAR; PG8_WAIT_L(0); PG8_MMA(0, 1, At, B1); PG8_BAR;
            PG8_LDA(At, 0, 1); PG8_STAGE(PG8_SA(0, 0), a2, voffA);
            PG8_BAR; PG8_WAIT_L(0); PG8_MMA(1, 0, At, B0); PG8_BAR; PG8_SCHED;
            PG8_STAGE(PG8_SB(0, 1), b2 + hstep, voffB);
            PG8_WAIT_V(6); PG8_BAR; PG8_MMA(1, 1, At, B1); PG8_BAR;
            PG8_LDB(B0, 1, 0); PG8_SCHED; PG8_LDA(At, 1, 0); PG8_STAGE(PG8_SA(0, 1), a2 + hstep, voffA);
            PG8_WAIT_L(8); PG8_BAR; PG8_WAIT_L(0); PG8_MMA(0, 0, At, B0); PG8_BAR; PG8_SCHED;
            PG8_LDB(B1, 1, 1); PG8_STAGE(PG8_SB(1, 0), b3, voffB);
            PG8_BAR; PG8_WAIT_L(0); PG8_MMA(0, 1, At, B1); PG8_BAR;
            PG8_LDA(At, 1, 1); PG8_STAGE(PG8_SA(1, 0), a3, voffA);
            PG8_BAR; PG8_WAIT_L(0); PG8_MMA(1, 0, At, B0); PG8_BAR; PG8_SCHED;
            PG8_STAGE(PG8_SB(1, 1), b3 + hstep, voffB);
            PG8_WAIT_V(6); PG8_BAR; PG8_MMA(1, 1, At, B1); PG8_BAR;
            }
        }
        if constexpr (ALIGN_EPI) { if (wr == 0) PG8_BAR; }
        if constexpr (FP8) asm volatile("s_nop 15\n\ts_nop 15" ::: "memory");
        if constexpr (!Epi::AFTER_DRAIN) { E(acc, cur, wr, wc, fr, fq); S.done(cur); }
        if (!has_next) break;
#pragma unroll
        for (int a = 0; a < 2; ++a)
#pragma unroll
            for (int b = 0; b < 2; ++b)
#pragma unroll
                for (int m = 0; m < 4; ++m)
#pragma unroll
                    for (int n = 0; n < 2; ++n) acc[a][b][m][n] = (f32x4){0.f, 0.f, 0.f, 0.f};
        cur = nxt; cA = nA; cB = nB; ++ui;
        if constexpr (ALIGN_EPI) { if (wr == 1) PG8_BAR; }
    }
    PG8_WAIT_V(0);
    if constexpr (!ALIGN_EPI) { if (wr == 0) PG8_BAR; }
    PG8_BAR;
    if constexpr (Epi::AFTER_DRAIN) { E.fused(acc, cur, wr, wc, fr, fq, lds, wid, lane); S.done(cur); }
#undef PG8_SA
#undef PG8_SB
#undef PG8_STAGE
#undef PG8_LDA
#undef PG8_LDB
#undef PG8_MMA
#undef PG8_WAIT_V
#undef PG8_WAIT_L
#undef PG8_BAR
#undef PG8_SCHED
}
}

#define PG8_SP2 true
#define PG8_ALIGN true

namespace att {
using bf16 = __hip_bfloat16;
constexpr int   D = 128, NW = 8, QBLK = 32, KVBLK = 64;
constexpr float SCALE = 0.088388347648318440f, LOG2E = 1.4426950408889634f, CS = SCALE * LOG2E;
constexpr float THR2 = 8.f * LOG2E;
constexpr int LDQ = 8704, LDK = 8704;
constexpr size_t SHM_V = KVBLK * D * 2, SHM_K = KVBLK * D * 2, SHM_ATTN = 2 * SHM_V + 2 * SHM_K + NW * 64 * 4;
using bf16x8 = __attribute__((ext_vector_type(8))) short;
using s16x4  = __attribute__((ext_vector_type(4))) short;
using f32x16 = __attribute__((ext_vector_type(16))) float;
using u32x4  = __attribute__((ext_vector_type(4))) unsigned;
#define KSWZ(row, colB) ((row) * 256 + ((colB) ^ (((row) & 7) << 4)))
#define SBAR() __builtin_amdgcn_sched_barrier(0)
__device__ __forceinline__ int crow(int r, int hi) { return (r & 3) + 8 * (r >> 2) + 4 * hi; }
__device__ __forceinline__ unsigned cvtpk(float lo, float hi) {
  unsigned r; asm volatile("v_cvt_pk_bf16_f32 %0, %1, %2" : "=v"(r) : "v"(lo), "v"(hi)); return r;
}
#ifndef ATT_PV_PRIO
#define ATT_PV_PRIO 1
#endif
#ifndef ATT_BIAS_INIT
#define ATT_BIAS_INIT 0
#endif
#ifndef ATT_SDEPTH
#define ATT_SDEPTH 1
#endif
template <bool WIN>
__device__ __forceinline__ void partialSM(f32x16& p0, f32x16& p1, float& m_reg, float& mn, float& alpha, float dqh, float nsl) {
#if !ATT_BIAS_INIT
#pragma unroll
  for (int r = 0; r < 16; ++r) { const float d = fabsf(dqh - (float)((r & 3) + 8 * (r >> 2))); float t = fmaf(d, nsl, p0[r]); if (WIN) t = d <= 128.f ? t : -1e30f; p0[r] = t; }
#pragma unroll
  for (int r = 0; r < 16; ++r) { const float d = fabsf(dqh - (float)(32 + (r & 3) + 8 * (r >> 2))); float t = fmaf(d, nsl, p1[r]); if (WIN) t = d <= 128.f ? t : -1e30f; p1[r] = t; }
#endif
  float pmax = p0[0];
#pragma unroll
  for (int r = 1; r < 16; ++r) pmax = fmaxf(pmax, p0[r]);
#pragma unroll
  for (int r = 0; r < 16; ++r) pmax = fmaxf(pmax, p1[r]);
  { auto rr = __builtin_amdgcn_permlane32_swap(__float_as_uint(pmax), __float_as_uint(pmax), false, false);
    pmax = fmaxf(__uint_as_float(rr[0]), __uint_as_float(rr[1])); }
  if (__builtin_expect(__all(pmax - m_reg <= THR2), 1)) { mn = m_reg; alpha = 1.f; }
  else { mn = fmaxf(m_reg, pmax); alpha = __builtin_amdgcn_exp2f(m_reg - mn); m_reg = mn; }
#pragma unroll
  for (int r = 0; r < 16; ++r) p0[r] -= mn;
#pragma unroll
  for (int r = 0; r < 16; ++r) p1[r] -= mn;
#pragma unroll
  for (int r = 0; r < 16; ++r) p0[r] = __builtin_amdgcn_exp2f(p0[r]);
}
__device__ __forceinline__ void finishSM(f32x16& p0, f32x16& p1, float alpha, float& l_reg, bf16x8& pa0, bf16x8& pa1, bf16x8& pa2, bf16x8& pa3) {
#pragma unroll
  for (int r = 0; r < 16; ++r) p1[r] = __builtin_amdgcn_exp2f(p1[r]);
  float ps = 0;
#pragma unroll
  for (int r = 0; r < 16; ++r) ps += p0[r];
#pragma unroll
  for (int r = 0; r < 16; ++r) ps += p1[r];
  { auto rr = __builtin_amdgcn_permlane32_swap(__float_as_uint(ps), __float_as_uint(ps), false, false);
    ps = __uint_as_float(rr[0]) + __uint_as_float(rr[1]); }
  l_reg = l_reg * alpha + ps;
#define PK4(P, BASE, OUT) do { unsigned a0 = cvtpk(P[BASE + 0], P[BASE + 1]), a1 = cvtpk(P[BASE + 2], P[BASE + 3]);   \
    unsigned b0 = cvtpk(P[BASE + 4], P[BASE + 5]), b1 = cvtpk(P[BASE + 6], P[BASE + 7]);                              \
    auto r0 = __builtin_amdgcn_permlane32_swap(a0, b0, false, false); auto r1 = __builtin_amdgcn_permlane32_swap(a1, b1, false, false); \
    u32x4 w = {r0[0], r1[0], r0[1], r1[1]}; OUT = *reinterpret_cast<bf16x8*>(&w); } while (0)
  PK4(p0, 0, pa0); PK4(p0, 8, pa1); PK4(p1, 0, pa2); PK4(p1, 8, pa3);
#undef PK4
}
template <bool WIN>
__device__ __forceinline__ void qkt(f32x16& p0, f32x16& p1, const bf16* Ks, const bf16x8* qr, int r32, int hi, float dqh, float nsl) {
#if ATT_BIAS_INIT
#pragma unroll
  for (int r = 0; r < 16; ++r) { const float d = fabsf(dqh - (float)((r & 3) + 8 * (r >> 2))); float b = nsl * d; if (WIN) b = d <= 128.f ? b : -1e30f; p0[r] = b; }
#pragma unroll
  for (int r = 0; r < 16; ++r) { const float d = fabsf(dqh - (float)(32 + (r & 3) + 8 * (r >> 2))); float b = nsl * d; if (WIN) b = d <= 128.f ? b : -1e30f; p1[r] = b; }
#else
  p0 = f32x16{}; p1 = f32x16{};
#endif
#pragma unroll
  for (int d0 = 0; d0 < 8; ++d0) { int cb = (d0 * 16 + hi * 8) * 2;
    bf16x8 b0 = *reinterpret_cast<const bf16x8*>((const char*)Ks + KSWZ(r32, cb));
    bf16x8 b1 = *reinterpret_cast<const bf16x8*>((const char*)Ks + KSWZ(32 + r32, cb));
    p0 = __builtin_amdgcn_mfma_f32_32x32x16_bf16(b0, qr[d0], p0, 0, 0, 0);
    p1 = __builtin_amdgcn_mfma_f32_32x32x16_bf16(b1, qr[d0], p1, 0, 0, 0); }
}
__device__ __forceinline__ int v_st(int k, int c) { const int kk = (k & ~0xC) | ((k & 4) << 1) | ((k & 8) >> 1); return ((kk >> 3) * 4 + (c >> 5)) * 512 + ((kk & 7) * 32 + (c & 31)) * 2; }
__device__ __forceinline__ int v_rd_base(int lane) { return ((lane & 3) << 3) | (((lane >> 2) & 3) << 6) | (((lane >> 4) & 1) << 5) | (((lane >> 5) & 1) << 8); }
constexpr int v_rd_off(int d0, int ks, int half) { return d0 * 512 + ks * 4096 + half * 2048; }
template <int OFF> __device__ __forceinline__ s16x4 tr_read(int vb) {
  s16x4 r; asm volatile("ds_read_b64_tr_b16 %0, %1 offset:%2" : "=&v"(r) : "v"(vb), "i"(OFF) : "memory"); return r;
}
template <int D0> __device__ __forceinline__ void pv_one(f32x16& od, int vb, bf16x8 pa0, bf16x8 pa1, bf16x8 pa2, bf16x8 pa3) {
  const s16x4 l0 = tr_read<v_rd_off(D0, 0, 0)>(vb), h0 = tr_read<v_rd_off(D0, 0, 1)>(vb), l1 = tr_read<v_rd_off(D0, 1, 0)>(vb), h1 = tr_read<v_rd_off(D0, 1, 1)>(vb);
  const s16x4 l2 = tr_read<v_rd_off(D0, 2, 0)>(vb), h2 = tr_read<v_rd_off(D0, 2, 1)>(vb), l3 = tr_read<v_rd_off(D0, 3, 0)>(vb), h3 = tr_read<v_rd_off(D0, 3, 1)>(vb);
  asm volatile("s_waitcnt lgkmcnt(0)" ::: "memory"); SBAR();
#define PK(L, H) (bf16x8){L[0], L[1], L[2], L[3], H[0], H[1], H[2], H[3]}
  od = __builtin_amdgcn_mfma_f32_32x32x16_bf16(pa0, PK(l0, h0), od, 0, 0, 0);
  od = __builtin_amdgcn_mfma_f32_32x32x16_bf16(pa1, PK(l1, h1), od, 0, 0, 0);
  od = __builtin_amdgcn_mfma_f32_32x32x16_bf16(pa2, PK(l2, h2), od, 0, 0, 0);
  od = __builtin_amdgcn_mfma_f32_32x32x16_bf16(pa3, PK(l3, h3), od, 0, 0, 0);
#undef PK
}
__device__ __forceinline__ void pv_d0(f32x16* o, int vb, bf16x8 pa0, bf16x8 pa1, bf16x8 pa2, bf16x8 pa3) {
  pv_one<0>(o[0], vb, pa0, pa1, pa2, pa3); pv_one<1>(o[1], vb, pa0, pa1, pa2, pa3); pv_one<2>(o[2], vb, pa0, pa1, pa2, pa3); pv_one<3>(o[3], vb, pa0, pa1, pa2, pa3);
}

template <bool WIN, bool OUTBF>
__device__ __forceinline__ void attn_body(const bf16* __restrict__ Qb, const bf16* __restrict__ Kh, const bf16* __restrict__ Vh,
                                          void* __restrict__ Ob, int ldo, int seq, char* lds, int dq0, float nsl, float m0, float l0, int tid_in) {
  unsigned ones_ = ~0u; asm volatile("" : "+s"(ones_)); int tid_ = tid_in * 64 + (int)__builtin_amdgcn_mbcnt_hi(ones_, __builtin_amdgcn_mbcnt_lo(ones_, 0u)); asm volatile("" : "+v"(tid_));
  const int tid = tid_, wid = tid >> 6, lane = tid & 63, r32 = lane & 31, hi = lane >> 5;
  bf16* V_lds = (bf16*)lds; bf16* K_lds = (bf16*)(lds + 2 * SHM_V);
  float* ws = (float*)(lds + 2 * SHM_V + 2 * SHM_K) + wid * 64; float* li_l = ws; float* al_l = ws + 32;
  float m_reg = m0, l_reg = l0; f32x16 o[4]; bf16x8 qr[8];
  { float zf = 0.f; asm volatile("" : "+v"(zf));
    _Pragma("unroll") for (int d = 0; d < 4; ++d) _Pragma("unroll") for (int r = 0; r < 16; ++r) o[d][r] = zf; }
  const bf16* Qw = Qb + (long)(wid * QBLK + r32) * LDQ + hi * 8;
#pragma unroll
  for (int d0 = 0; d0 < 8; ++d0) qr[d0] = *reinterpret_cast<const bf16x8*>(Qw + d0 * 16);
  const float dql = (float)(dq0 + wid * QBLK + r32 - 4 * hi);
  const int sr = tid >> 4, sc = (tid & 15) * 8, vst0 = v_st(sr, sc), vst1 = v_st(32 + sr, sc);
  const int vb0 = (int)(uintptr_t)V_lds + v_rd_base(lane);
  struct { bf16x8 vs0, vs1, ks0, ks1; } sr_[ATT_SDEPTH];
#define LD8(p) (*reinterpret_cast<const bf16x8*>(p))
#define SLOAD(i, k0) do { sr_[i].vs0 = LD8(&Vh[(long)((k0) + sr) * LDK + sc]); sr_[i].vs1 = LD8(&Vh[(long)((k0) + 32 + sr) * LDK + sc]); \
    sr_[i].ks0 = LD8(&Kh[(long)((k0) + sr) * LDK + sc]); sr_[i].ks1 = LD8(&Kh[(long)((k0) + 32 + sr) * LDK + sc]); } while (0)
#define SWRITE(b, i) do { *(bf16x8*)((char*)V_lds + (b) * SHM_V + vst0) = sr_[i].vs0;          \
    *(bf16x8*)((char*)V_lds + (b) * SHM_V + vst1) = sr_[i].vs1; int kc = sc * 2;               \
    *(bf16x8*)((char*)K_lds + (b) * SHM_K + KSWZ(sr, kc)) = sr_[i].ks0;                       \
    *(bf16x8*)((char*)K_lds + (b) * SHM_K + KSWZ(32 + sr, kc)) = sr_[i].ks1; } while (0)
#define SWAIT() do { if (ATT_SDEPTH == 2) asm volatile("s_waitcnt vmcnt(4)" ::: "memory"); else asm volatile("s_waitcnt vmcnt(0)" ::: "memory"); } while (0)
#define RESC(a) do { if (__any((a) < 1.f)) { if (hi == 0) al_l[r32] = (a); asm volatile("s_waitcnt lgkmcnt(0)" ::: "memory"); \
    _Pragma("unroll") for (int d = 0; d < 4; ++d) _Pragma("unroll") for (int r = 0; r < 16; ++r) o[d][r] *= al_l[crow(r, hi)]; } } while (0)
  f32x16 pA0, pA1, pB0, pB1; float mnA, mnB, alA, alB; bf16x8 pa0, pa1, pa2, pa3; const int NT = seq / KVBLK;
  const int r0w = dq0 + __builtin_amdgcn_readfirstlane(wid) * QBLK;
  const int tlo = WIN ? (r0w - 128 < 0 ? 0 : (r0w - 128) / KVBLK) : 0, thi = WIN ? (r0w + 31 + 128) / KVBLK : 0x7fffffff;
#define TVALID(jt) ((jt) >= tlo && (jt) <= thi)
#define QKT(P0, P1, KS, jt, DQ) do { if (TVALID(jt)) qkt<WIN>(P0, P1, KS, qr, r32, hi, DQ, nsl); else { _Pragma("unroll") for (int r_ = 0; r_ < 16; ++r_) { P0[r_] = -1e30f; P1[r_] = -1e30f; } } } while (0)
#define PV(VB, jt) do { if (TVALID(jt)) pv_d0(o, VB, pa0, pa1, pa2, pa3); } while (0)
  constexpr int SE = 0, SO = ATT_SDEPTH - 1;
  SLOAD(SE, 0); asm volatile("s_waitcnt vmcnt(0)" ::: "memory"); SWRITE(0, SE); __syncthreads();
  QKT(pA0, pA1, K_lds, 0, dql); partialSM<WIN>(pA0, pA1, m_reg, mnA, alA, dql, nsl);
  SLOAD(SO, KVBLK); if (ATT_SDEPTH == 2) { if (2 < NT) SLOAD(SE, 2 * KVBLK); }
  SWAIT(); SWRITE(1, SO); __syncthreads();
  for (int j = 1; j + 1 < NT; j += 2) {
    SBAR(); QKT(pB0, pB1, (bf16*)((char*)K_lds + SHM_K), j, dql - (float)(j * KVBLK));
    finishSM(pA0, pA1, alA, l_reg, pa0, pa1, pa2, pa3); SBAR();
    SLOAD(SO, (j + ATT_SDEPTH) * KVBLK); SBAR();
    PV(vb0, j - 1); partialSM<WIN>(pB0, pB1, m_reg, mnB, alB, dql - (float)(j * KVBLK), nsl);
    __syncthreads(); SWAIT(); SWRITE(0, SE);
    RESC(alB); __syncthreads();
    SBAR(); QKT(pA0, pA1, K_lds, j + 1, dql - (float)((j + 1) * KVBLK));
    finishSM(pB0, pB1, alB, l_reg, pa0, pa1, pa2, pa3); SBAR();
    if (ATT_SDEPTH == 1 || j + 3 < NT) SLOAD(SE, (j + 1 + ATT_SDEPTH) * KVBLK); SBAR();
    PV(vb0 + (int)SHM_V, j); partialSM<WIN>(pA0, pA1, m_reg, mnA, alA, dql - (float)((j + 1) * KVBLK), nsl);
    __syncthreads(); SWAIT(); SWRITE(1, SO);
    RESC(alA); __syncthreads();
  }
  SBAR(); QKT(pB0, pB1, (bf16*)((char*)K_lds + SHM_K), NT - 1, dql - (float)((NT - 1) * KVBLK));
  finishSM(pA0, pA1, alA, l_reg, pa0, pa1, pa2, pa3); SBAR();
  PV(vb0, NT - 2); partialSM<WIN>(pB0, pB1, m_reg, mnB, alB, dql - (float)((NT - 1) * KVBLK), nsl);
  __syncthreads(); RESC(alB);
  finishSM(pB0, pB1, alB, l_reg, pa0, pa1, pa2, pa3); SBAR();
  PV(vb0 + (int)SHM_V, NT - 1);
  if (hi == 0) li_l[r32] = l_reg; asm volatile("s_waitcnt lgkmcnt(0)" ::: "memory");
  float rli[16];
#pragma unroll
  for (int r = 0; r < 16; ++r) rli[r] = __builtin_amdgcn_rcpf(li_l[crow(r, hi)]);
  if (OUTBF) { bf16* Ow = (bf16*)Ob + (long)(wid * QBLK) * ldo;
#pragma unroll
    for (int r = 0; r < 16; ++r) { const int orow = crow(r, hi);
#pragma unroll
      for (int d0 = 0; d0 < 4; ++d0) Ow[(long)orow * ldo + d0 * 32 + r32] = __float2bfloat16(o[d0][r] * rli[r]); }
  } else { float* Ow = (float*)Ob + (long)(wid * QBLK) * ldo;
#pragma unroll
    for (int r = 0; r < 16; ++r) { const int orow = crow(r, hi);
#pragma unroll
      for (int d0 = 0; d0 < 4; ++d0) Ow[(long)orow * ldo + d0 * 32 + r32] = o[d0][r] * rli[r]; }
  }
  __syncthreads();
#undef TVALID
#undef QKT
#undef PV
#undef LD8
#undef SLOAD
#undef SWRITE
#undef SWAIT
#undef RESC
}

__device__ __forceinline__ void finishSM_noexp(f32x16& p0, f32x16& p1, float& l_reg, bf16x8& pa0, bf16x8& pa1, bf16x8& pa2, bf16x8& pa3) {
  float ps = 0, ps2 = 0;
#pragma unroll
  for (int r = 0; r < 16; ++r) { ps += p0[r]; ps2 += p1[r]; }
  ps += ps2;
  { auto rr = __builtin_amdgcn_permlane32_swap(__float_as_uint(ps), __float_as_uint(ps), false, false);
    ps = __uint_as_float(rr[0]) + __uint_as_float(rr[1]); }
  l_reg += ps;
#define PK4(P, BASE, OUT) do { unsigned a0 = cvtpk(P[BASE + 0], P[BASE + 1]), a1 = cvtpk(P[BASE + 2], P[BASE + 3]);   \
    unsigned b0 = cvtpk(P[BASE + 4], P[BASE + 5]), b1 = cvtpk(P[BASE + 6], P[BASE + 7]);                              \
    auto r0 = __builtin_amdgcn_permlane32_swap(a0, b0, false, false); auto r1 = __builtin_amdgcn_permlane32_swap(a1, b1, false, false); \
    u32x4 w = {r0[0], r1[0], r0[1], r1[1]}; OUT = *reinterpret_cast<bf16x8*>(&w); } while (0)
  PK4(p0, 0, pa0); PK4(p0, 8, pa1); PK4(p1, 0, pa2); PK4(p1, 8, pa3);
#undef PK4
}
__device__ __forceinline__ void qkt_diff(f32x16& p0, f32x16& p1, const bf16* Ks, const bf16x8* qr, int r32, int hi, bool diag, float sg, float base, float dqh, float nsl, float mref) {
  if (diag) {
#pragma unroll
    for (int r = 0; r < 16; ++r) { p0[r] = fmaf(nsl, fabsf(dqh - (float)((r & 3) + 8 * (r >> 2))), -mref); p1[r] = fmaf(nsl, fabsf(dqh - (float)(32 + (r & 3) + 8 * (r >> 2))), -mref); }
  } else {
#pragma unroll
    for (int r = 0; r < 16; ++r) { p0[r] = fmaf(sg, (float)((r & 3) + 8 * (r >> 2)), base); p1[r] = fmaf(sg, (float)(32 + (r & 3) + 8 * (r >> 2)), base); }
  }
#pragma unroll
  for (int d0 = 0; d0 < 8; ++d0) { int cb = (d0 * 16 + hi * 8) * 2;
    bf16x8 b0 = *reinterpret_cast<const bf16x8*>((const char*)Ks + KSWZ(r32, cb));
    bf16x8 b1 = *reinterpret_cast<const bf16x8*>((const char*)Ks + KSWZ(32 + r32, cb));
    p0 = __builtin_amdgcn_mfma_f32_32x32x16_bf16(b0, qr[d0], p0, 0, 0, 0);
    p1 = __builtin_amdgcn_mfma_f32_32x32x16_bf16(b1, qr[d0], p1, 0, 0, 0); }
}
#define MX3(a, b, c) __builtin_fmaxf(__builtin_fmaxf((a), (b)), (c))
constexpr size_t SHM_DIFF = 2 * (2 * SHM_V) + 2 * SHM_K + NW * 64 * 4;
template <bool SECOND>
__device__ __forceinline__ void attn_diff_body(const bf16* __restrict__ Qb, const bf16* __restrict__ Kh, const bf16* __restrict__ Vh, float* Scr, bf16* Yd, int ldy,
                                               char* lds, int dq0, float nsl, float lam, float oscale, const float* __restrict__ g, int seq, int tid_in) {
  unsigned ones_ = ~0u; asm volatile("" : "+s"(ones_)); int tid_ = tid_in * 64 + (int)__builtin_amdgcn_mbcnt_hi(ones_, __builtin_amdgcn_mbcnt_lo(ones_, 0u)); asm volatile("" : "+v"(tid_));
  const int tid = tid_, wid = tid >> 6, lane = tid & 63, r32 = lane & 31, hi = lane >> 5;
  bf16* V_lds = (bf16*)lds; bf16* K_lds = (bf16*)(lds + 4 * SHM_V);
  float* ws = (float*)(lds + 4 * SHM_V + 2 * SHM_K) + wid * 64; float* li_l = ws; float* al_l = ws + 32;
  float mref = 0.f, l_reg = 0.f; f32x16 o[8]; bf16x8 qr[8];
  { float zf = 0.f; asm volatile("" : "+v"(zf));
    _Pragma("unroll") for (int d = 0; d < 8; ++d) _Pragma("unroll") for (int r = 0; r < 16; ++r) o[d][r] = zf; }
  const bf16* Qw = Qb + (long)(wid * QBLK + r32) * LDQ + hi * 8;
#pragma unroll
  for (int d0 = 0; d0 < 8; ++d0) qr[d0] = *reinterpret_cast<const bf16x8*>(Qw + d0 * 16);
  const float dql = (float)(dq0 + wid * QBLK + r32 - 4 * hi);
  const int vb0 = (int)(uintptr_t)V_lds + v_rd_base(lane);
  const int widu = __builtin_amdgcn_readfirstlane(wid);
  const unsigned lds0 = (unsigned)(uintptr_t)lds;
#define GLDS(src, ldsoff) __builtin_amdgcn_global_load_lds((const unsigned*)(src), (__attribute__((address_space(3))) unsigned*)(unsigned)(ldsoff), 16, 0, 0)
#define STAGE(k0, b) do { const bf16* kt = Kh + (long)(k0) * LDK; const bf16* vt = Vh + (long)(k0) * LDK; \
    _Pragma("unroll") for (int q = 0; q < 2; ++q) { const int row = (wid * 2 + q) * 4 + (lane >> 4), c = (lane & 15) ^ (row & 7); \
      GLDS(kt + row * LDK + c * 8, lds0 + 4 * (unsigned)SHM_V + (b) * (unsigned)SHM_K + (widu * 2 + q) * 1024); } \
    _Pragma("unroll") for (int q = 0; q < 4; ++q) { const int ob = (wid * 4 + q) * 1024 + lane * 16, img = ob >> 14, oi = ob & 16383, st = oi >> 9, w = oi & 511; \
      const int kk = (st >> 2) * 8 + (w >> 6), k = (kk & ~0xC) | ((kk & 4) << 1) | ((kk & 8) >> 1), c = (st & 3) * 32 + ((w & 63) >> 1); \
      GLDS(vt + k * LDK + img * 128 + c, lds0 + (b) * 2 * (unsigned)SHM_V + (widu * 4 + q) * 1024); } } while (0)
  f32x16 p0, p1; float al; bf16x8 pa0, pa1, pa2, pa3; const int NT = seq / KVBLK;
  STAGE(0, 0); asm volatile("s_waitcnt vmcnt(0)" ::: "memory"); __syncthreads();
  for (int j = 0; j < NT; ++j) {
    const int b = j & 1;
    if (j + 1 < NT) STAGE((j + 1) * KVBLK, b ^ 1);
    SBAR();
    { const int dw = dq0 + widu * QBLK - j * KVBLK;
      const bool diag = (dw > -32) && (dw < 64); const float sgn = dw >= 64 ? 1.f : -1.f; const float dqh = dql - (float)(j * KVBLK);
      qkt_diff(p0, p1, (bf16*)((char*)K_lds + b * SHM_K), qr, r32, hi, diag, -nsl * sgn, fmaf(nsl * sgn, dqh, -mref), dqh, nsl, mref); }
    { float a = MX3(p0[0], p0[1], p1[0]), c = MX3(p0[2], p0[3], p1[1]); a = MX3(a, p1[2], p1[3]);
#pragma unroll
      for (int r = 4; r < 16; r += 4) { a = MX3(a, p0[r], p0[r + 1]); c = MX3(c, p0[r + 2], p0[r + 3]); a = MX3(a, p1[r], p1[r + 1]); c = MX3(c, p1[r + 2], p1[r + 3]); }
      float pmax = __builtin_fmaxf(a, c);
      { auto rr = __builtin_amdgcn_permlane32_swap(__float_as_uint(pmax), __float_as_uint(pmax), false, false); pmax = __builtin_fmaxf(__uint_as_float(rr[0]), __uint_as_float(rr[1])); }
      if (__builtin_expect(!__all(pmax <= THR2), 0)) {
        const float dl = __builtin_fmaxf(pmax, 0.f); mref += dl; al = __builtin_amdgcn_exp2f(-dl); l_reg *= al;
#pragma unroll
        for (int r = 0; r < 16; ++r) { p0[r] -= dl; p1[r] -= dl; }
        if (hi == 0) al_l[r32] = al; asm volatile("s_waitcnt lgkmcnt(0)" ::: "memory");
#pragma unroll
        for (int d = 0; d < 8; ++d)
#pragma unroll
          for (int r = 0; r < 16; ++r) o[d][r] *= al_l[crow(r, hi)]; }
#pragma unroll
      for (int r = 0; r < 16; ++r) { p0[r] = __builtin_amdgcn_exp2f(p0[r]); p1[r] = __builtin_amdgcn_exp2f(p1[r]); } }
    finishSM_noexp(p0, p1, l_reg, pa0, pa1, pa2, pa3);
    SBAR();
#if ATT_PV_PRIO
    __builtin_amdgcn_s_setprio(1);
#endif
    pv_d0(o, vb0 + b * 2 * (int)SHM_V, pa0, pa1, pa2, pa3);
    pv_d0(o + 4, vb0 + b * 2 * (int)SHM_V + (int)SHM_V, pa0, pa1, pa2, pa3);
#if ATT_PV_PRIO
    __builtin_amdgcn_s_setprio(0);
#endif
    SBAR();
    asm volatile("s_waitcnt vmcnt(0)" ::: "memory");
    __syncthreads();
  }
  if (hi == 0) li_l[r32] = l_reg; asm volatile("s_waitcnt lgkmcnt(0)" ::: "memory");
  float rli[16];
#pragma unroll
  for (int r = 0; r < 16; ++r) rli[r] = __builtin_amdgcn_rcpf(li_l[crow(r, hi)]);
  float* sw = Scr + (size_t)wid * (16 * 8 * 64) + lane;
  if (!SECOND) {
#pragma unroll
    for (int r = 0; r < 16; ++r)
#pragma unroll
      for (int d0 = 0; d0 < 8; ++d0) sw[(r * 8 + d0) * 64] = o[d0][r] * rli[r];
  } else {
    float gq[8];
#pragma unroll
    for (int d0 = 0; d0 < 8; ++d0) gq[d0] = g[d0 * 32 + r32] * oscale;
#pragma unroll
    for (int r = 0; r < 16; ++r) {
      float dv[8]; float ss = 0.f;
#pragma unroll
      for (int d0 = 0; d0 < 8; ++d0) { dv[d0] = sw[(r * 8 + d0) * 64] - lam * (o[d0][r] * rli[r]); ss += dv[d0] * dv[d0]; }
#define DPPF_(x, ctrl) __int_as_float(__builtin_amdgcn_update_dpp(0, __float_as_int(x), ctrl, 0xF, 0xF, false))
      ss += DPPF_(ss, 0xB1); ss += DPPF_(ss, 0x4E); ss += DPPF_(ss, 0x141); ss += DPPF_(ss, 0x140);
      ss += __int_as_float(__builtin_amdgcn_ds_swizzle(__float_as_int(ss), 0x401F));
#undef DPPF_
      const float rs = 1.f / sqrtf(ss * (1.f / 256.f) + 1e-5f);
      bf16* yrow = Yd + (long)(wid * QBLK + crow(r, hi)) * ldy + r32;
#pragma unroll
      for (int d0 = 0; d0 < 8; ++d0) yrow[d0 * 32] = __float2bfloat16(dv[d0] * rs * gq[d0]);
    }
  }
  __syncthreads();
#undef GLDS
#undef STAGE
}

constexpr size_t SHM_WIN = 2 * SHM_V + 2 * SHM_K + NW * 64 * 4;
__device__ __forceinline__ void attn_win_body(const bf16* __restrict__ Qb, const bf16* __restrict__ Kh, const bf16* __restrict__ Vh, bf16* __restrict__ Ob, int ldo,
                                              char* lds, int dq0, float nsl, float sink_l2, int seq, int tid_in) {
  unsigned ones_ = ~0u; asm volatile("" : "+s"(ones_)); int tid_ = tid_in * 64 + (int)__builtin_amdgcn_mbcnt_hi(ones_, __builtin_amdgcn_mbcnt_lo(ones_, 0u)); asm volatile("" : "+v"(tid_));
  const int tid = tid_, wid = tid >> 6, lane = tid & 63, r32 = lane & 31, hi = lane >> 5;
  bf16* V_lds = (bf16*)lds; bf16* K_lds = (bf16*)(lds + 2 * SHM_V);
  float* ws = (float*)(lds + 2 * SHM_V + 2 * SHM_K) + wid * 64; float* li_l = ws; float* al_l = ws + 32;
  float mref = 0.f, l_reg = __builtin_amdgcn_exp2f(sink_l2); f32x16 o[4]; bf16x8 qr[8];
  { float zf = 0.f; asm volatile("" : "+v"(zf));
    _Pragma("unroll") for (int d = 0; d < 4; ++d) _Pragma("unroll") for (int r = 0; r < 16; ++r) o[d][r] = zf; }
  const bf16* Qw = Qb + (long)(wid * QBLK + r32) * LDQ + hi * 8;
#pragma unroll
  for (int d0 = 0; d0 < 8; ++d0) qr[d0] = *reinterpret_cast<const bf16x8*>(Qw + d0 * 16);
  const float dql = (float)(dq0 + wid * QBLK + r32 - 4 * hi);
  const int vb0 = (int)(uintptr_t)V_lds + v_rd_base(lane);
  const int widu = __builtin_amdgcn_readfirstlane(wid);
  const unsigned lds0 = (unsigned)(uintptr_t)lds;
  const int r0w = dq0 + widu * QBLK;
  const int tlo = r0w - 128 < 0 ? 0 : (r0w - 128) / KVBLK, thi = (r0w + 31 + 128) / KVBLK;
#define GLDS(src, ldsoff) __builtin_amdgcn_global_load_lds((const unsigned*)(src), (__attribute__((address_space(3))) unsigned*)(unsigned)(ldsoff), 16, 0, 0)
#define STAGE(k0, b) do { const bf16* kt = Kh + (long)(k0) * LDK; const bf16* vt = Vh + (long)(k0) * LDK; \
    _Pragma("unroll") for (int q = 0; q < 2; ++q) { const int row = (wid * 2 + q) * 4 + (lane >> 4), c = (lane & 15) ^ (row & 7); \
      GLDS(kt + row * LDK + c * 8, lds0 + 2 * (unsigned)SHM_V + (b) * (unsigned)SHM_K + (widu * 2 + q) * 1024); } \
    _Pragma("unroll") for (int q = 0; q < 2; ++q) { const int oi = (wid * 2 + q) * 1024 + lane * 16, st = oi >> 9, w = oi & 511; \
      const int kk = (st >> 2) * 8 + (w >> 6), k = (kk & ~0xC) | ((kk & 4) << 1) | ((kk & 8) >> 1), c = (st & 3) * 32 + ((w & 63) >> 1); \
      GLDS(vt + k * LDK + c, lds0 + (b) * (unsigned)SHM_V + (widu * 2 + q) * 1024); } } while (0)
  f32x16 p0, p1; float al; bf16x8 pa0, pa1, pa2, pa3; const int NT = seq / KVBLK;
  STAGE(0, 0); asm volatile("s_waitcnt vmcnt(0)" ::: "memory"); __syncthreads();
  for (int j = 0; j < NT; ++j) {
    const int b = j & 1;
    if (j + 1 < NT) STAGE((j + 1) * KVBLK, b ^ 1);
    SBAR();
    if (j >= tlo && j <= thi) {
      const float dqh = dql - (float)(j * KVBLK);
#pragma unroll
      for (int r = 0; r < 16; ++r) { const float d0_ = fabsf(dqh - (float)((r & 3) + 8 * (r >> 2))), d1_ = fabsf(dqh - (float)(32 + (r & 3) + 8 * (r >> 2)));
        p0[r] = d0_ <= 128.f ? fmaf(nsl, d0_, -mref) : -1e30f; p1[r] = d1_ <= 128.f ? fmaf(nsl, d1_, -mref) : -1e30f; }
      { const bf16* Ks = (const bf16*)((const char*)K_lds + b * SHM_K);
#pragma unroll
        for (int d0 = 0; d0 < 8; ++d0) { int cb = (d0 * 16 + hi * 8) * 2;
          bf16x8 b0 = *reinterpret_cast<const bf16x8*>((const char*)Ks + KSWZ(r32, cb));
          bf16x8 b1 = *reinterpret_cast<const bf16x8*>((const char*)Ks + KSWZ(32 + r32, cb));
          p0 = __builtin_amdgcn_mfma_f32_32x32x16_bf16(b0, qr[d0], p0, 0, 0, 0);
          p1 = __builtin_amdgcn_mfma_f32_32x32x16_bf16(b1, qr[d0], p1, 0, 0, 0); } }
      { float a = MX3(p0[0], p0[1], p1[0]), c = MX3(p0[2], p0[3], p1[1]); a = MX3(a, p1[2], p1[3]);
#pragma unroll
        for (int r = 4; r < 16; r += 4) { a = MX3(a, p0[r], p0[r + 1]); c = MX3(c, p0[r + 2], p0[r + 3]); a = MX3(a, p1[r], p1[r + 1]); c = MX3(c, p1[r + 2], p1[r + 3]); }
        float pmax = __builtin_fmaxf(a, c);
        { auto rr = __builtin_amdgcn_permlane32_swap(__float_as_uint(pmax), __float_as_uint(pmax), false, false); pmax = __builtin_fmaxf(__uint_as_float(rr[0]), __uint_as_float(rr[1])); }
        if (__builtin_expect(!__all(pmax <= THR2), 0)) {
          const float dl = __builtin_fmaxf(pmax, 0.f); mref += dl; al = __builtin_amdgcn_exp2f(-dl); l_reg *= al;
#pragma unroll
          for (int r = 0; r < 16; ++r) { p0[r] -= dl; p1[r] -= dl; }
          if (hi == 0) al_l[r32] = al; asm volatile("s_waitcnt lgkmcnt(0)" ::: "memory");
#pragma unroll
          for (int d = 0; d < 4; ++d)
#pragma unroll
            for (int r = 0; r < 16; ++r) o[d][r] *= al_l[crow(r, hi)]; }
#pragma unroll
        for (int r = 0; r < 16; ++r) { p0[r] = __builtin_amdgcn_exp2f(p0[r]); p1[r] = __builtin_amdgcn_exp2f(p1[r]); } }
      finishSM_noexp(p0, p1, l_reg, pa0, pa1, pa2, pa3);
      SBAR();
      pv_d0(o, vb0 + b * (int)SHM_V, pa0, pa1, pa2, pa3);
    }
    SBAR();
    asm volatile("s_waitcnt vmcnt(0)" ::: "memory");
    __syncthreads();
  }
  if (hi == 0) li_l[r32] = l_reg; asm volatile("s_waitcnt lgkmcnt(0)" ::: "memory");
  float rli[16];
#pragma unroll
  for (int r = 0; r < 16; ++r) rli[r] = __builtin_amdgcn_rcpf(li_l[crow(r, hi)]);
  bf16* Ow = Ob + (long)(wid * QBLK) * ldo;
#pragma unroll
  for (int r = 0; r < 16; ++r) { const int orow = crow(r, hi);
#pragma unroll
    for (int d0 = 0; d0 < 4; ++d0) Ow[(long)orow * ldo + d0 * 32 + r32] = __float2bfloat16(o[d0][r] * rli[r]); }
  __syncthreads();
#undef GLDS
#undef STAGE
}
#undef SBAR
#undef KSWZ
}

#define GAS __attribute__((address_space(1)))
#define LAS __attribute__((address_space(3)))
typedef unsigned short bf16;
typedef unsigned v4u __attribute__((ext_vector_type(4)));
typedef float f32x4 __attribute__((ext_vector_type(4)));
typedef short bf16x8 __attribute__((ext_vector_type(8)));
typedef GAS unsigned gu32;
typedef GAS unsigned long long gu64;
#define RLX_AGENT __ATOMIC_RELAXED, __HIP_MEMORY_SCOPE_AGENT
#define LDS_WAIT() asm volatile("s_waitcnt lgkmcnt(0)" ::: "memory")
#define VM_WAIT() asm volatile("s_waitcnt vmcnt(0)" ::: "memory")
__device__ __forceinline__ unsigned long long rt() { return __builtin_amdgcn_s_memrealtime(); }
__device__ __forceinline__ unsigned f2bf(float f) { unsigned u = __builtin_bit_cast(unsigned, f); return (u + 0x7fffu + ((u >> 16) & 1u)) >> 16; }
__device__ __forceinline__ unsigned pk2(float lo, float hi) { return f2bf(lo) | (f2bf(hi) << 16); }

#define XB_TMO      128
#define XB_XCNT(j)  (256  + 64 * (j))
#define XB_XSUB(j)  (1280 + 64 * (j))
#define XB_XGEN(j)  (2304 + 64 * (j))
#define XB_TOP      3328
#define XB_TOPGEN   3392
#define XCD_BAR_WORDS 3456
#define XB_SPIN_CAP (1u << 18)

__device__ __forceinline__ unsigned xb_ld(unsigned* p)              { return __hip_atomic_load(p, __ATOMIC_RELAXED, __HIP_MEMORY_SCOPE_AGENT); }
__device__ __forceinline__ unsigned xb_add(unsigned* p, unsigned v) { return __hip_atomic_fetch_add(p, v, __ATOMIC_RELAXED, __HIP_MEMORY_SCOPE_AGENT); }
__device__ __forceinline__ unsigned xb_xcc_id() { return (unsigned)__builtin_amdgcn_s_getreg((3 << 11) | 20) & 0xFu; }
#define XB_SPIN(cond, bar) do { unsigned _sp = 0; while (cond) { __builtin_amdgcn_s_sleep(1); \
    if ((++_sp & 255u) == 0u) { if (xb_ld(&(bar)[XB_TMO])) break; if (_sp > XB_SPIN_CAP) { atomicAdd(&(bar)[XB_TMO], 1u); break; } } } } while (0)

struct XcdBarrier {
    unsigned* bar; unsigned x;
    volatile LAS unsigned* st;
};

__device__ __forceinline__ XcdBarrier xcd_barrier_post(unsigned* bar, volatile LAS unsigned* st) {
    XcdBarrier b; b.bar = bar; b.x = xb_xcc_id(); b.st = st;
    if (threadIdx.x == 0) (void)xb_add(&bar[XB_XCNT(b.x)], 1u);
    return b;
}
__device__ __forceinline__ void xcd_barrier_complete(unsigned* bar, unsigned x, unsigned& nloc, unsigned& nx) {
    const unsigned G = gridDim.x * gridDim.y * gridDim.z;
    unsigned sum, cnt, mine, sp = 0u;
    for (;;) {
        sum = 0u; cnt = 0u; mine = 0u;
#pragma unroll
        for (unsigned j = 0; j < 16; ++j) { const unsigned c = xb_ld(&bar[XB_XCNT(j)]); sum += c; cnt += (c > 0u) ? 1u : 0u; mine = (j == x) ? c : mine; }
        if (sum == G) break;
        __builtin_amdgcn_s_sleep(1);
        if ((++sp & 255u) == 0u) { if (xb_ld(&bar[XB_TMO])) break; if (sp > XB_SPIN_CAP) { atomicAdd(&bar[XB_TMO], 1u); break; } }
    }
    nloc = mine > 0u ? mine : 1u; nx = cnt > 0u ? cnt : 1u;
}

__device__ __forceinline__ void xcd_barrier(const XcdBarrier& b) {
    asm volatile("s_waitcnt vmcnt(0)" ::: "memory");
    __syncthreads();
    if (threadIdx.x == 0) {
        unsigned* bar = b.bar;
        __builtin_amdgcn_s_waitcnt(0);
        unsigned nloc = b.st[0], nx = b.st[1];
        if (nloc == 0u) { xcd_barrier_complete(bar, b.x, nloc, nx); b.st[0] = nloc; b.st[1] = nx; }
        const unsigned old = xb_add(&bar[XB_XSUB(b.x)], 1u);
        const unsigned gen = old / nloc;
        if (old + 1u == (gen + 1u) * nloc) {
            __builtin_amdgcn_fence(__ATOMIC_RELEASE, "agent");
            asm volatile("s_waitcnt vmcnt(0)" ::: "memory");
            const unsigned og = xb_add(&bar[XB_TOP], 1u);
            const unsigned tg = og / nx;
            if (og + 1u == (tg + 1u) * nx) xb_add(&bar[XB_TOPGEN], 1u);
            else XB_SPIN(xb_ld(&bar[XB_TOPGEN]) == tg, bar);
            __builtin_amdgcn_fence(__ATOMIC_ACQUIRE, "agent");
            xb_add(&bar[XB_XGEN(b.x)], 1u);
            asm volatile("s_waitcnt vmcnt(0)" ::: "memory");
        } else {
            XB_SPIN(xb_ld(&bar[XB_XGEN(b.x)]) == gen, bar);
            __builtin_amdgcn_fence(__ATOMIC_ACQUIRE, "agent");
            asm volatile("s_waitcnt vmcnt(0)" ::: "memory");
        }
    }
    __syncthreads();
}

constexpr int NWAVES = 8;
constexpr int DM = 2048, SEQ = 2048, DEPTH = 4, CSEQ = 8, TC = CSEQ * SEQ, NCHUNK = 3, TPROMPT = 16 * SEQ, TTOT = 24 * SEQ;
constexpr int INC = 8704, DFF = 5504, NEXP = 8, DFE = 1024;
constexpr int ZQA = 0, ZKA = 1024, ZVA = 1280, ZQD = 1536, ZKD = 2560, ZVD = 3584, ZGA = 4608;
constexpr float LN_EPS = 1e-5f, ALPHA = 1.681792830507429f;
constexpr int SLOTS_MAX = 2 * TC + NEXP * 256;
constexpr int NSEG = TC / 64;
#define SEGROW(seg, w, i) (2 * (((i) >> 1) * (NSEG * 8) + (seg) * 8 + (w)) + ((i) & 1))
#ifndef FP8_DENSE_UP
#define FP8_DENSE_UP 1
#endif
#ifndef FP8_DENSE_DOWN
#define FP8_DENSE_DOWN 1
#endif
#ifndef FP8_MOE_UP
#define FP8_MOE_UP 1
#endif
#ifndef FP8_MOE_DOWN
#define FP8_MOE_DOWN 1
#endif
#ifndef FP8_INPROJ_QKV
#define FP8_INPROJ_QKV 0
#endif
constexpr float W8_SCALE = 128.f, U8_SCALE = 16.f;
constexpr float LO8_SCALE = 4096.f;
#ifndef FP8_INPROJ_GATES
#define FP8_INPROJ_GATES 1
#endif
constexpr size_t WL_WING8 = 18u << 20;
constexpr size_t WL_WING = 9u << 20;
constexpr int DFF8 = 5632;
constexpr int NPH = 11, NGID = 1 + NCHUNK * DEPTH * NPH;

constexpr size_t MiB = 1u << 20;
constexpr size_t WS_CTL = 0, CTL_ZERO_BYTES = 1 * MiB;
constexpr size_t WS_ROUTE = 1 * MiB, WS_TOKSLOT = WS_ROUTE + (size_t)TC * 16, WS_SLOTGATE = WS_TOKSLOT + (size_t)TC * 8, WS_SEGCNT = WS_SLOTGATE + (size_t)SLOTS_MAX * 4, WS_MOEOFF = WS_SEGCNT + (size_t)NSEG * 8 * 4;
static_assert(WS_MOEOFF + 64 <= 2 * MiB, "small arrays");
constexpr size_t WS_WL = 2 * MiB, WL_STRIDE = 50 * MiB, WL_WIN = 0, WL_WPAD = 34 * MiB, WL_WO = 42 * MiB;
constexpr size_t WS_WD = 202 * MiB, WD_STRIDE = 64 * MiB + MiB / 2, WD_W13 = 0, WD_W2 = 43 * MiB;
constexpr size_t WS_WM = 331 * MiB, WM_STRIDE = 96 * MiB, WM_W13 = 0, WM_W2 = 64 * MiB;
constexpr size_t WS_XB = 524 * MiB, WS_Z = 588 * MiB, WS_U = WS_Z, WS_HBG = WS_Z, WS_UM = WS_Z + 136 * MiB;
constexpr size_t WS_YAD = 860 * MiB, WS_ODIFF = 924 * MiB, WS_OM = 924 * MiB, WS_MERGED = 1052 * MiB, WS_MIX = 1116 * MiB, WS_XLO = 1180 * MiB, WS_XB8 = 1244 * MiB, WS_U8 = 1276 * MiB, WS_END = 1364 * MiB;
static_assert((size_t)INC * DM * 2 <= 34 * MiB && (size_t)2 * DFF * DM * 2 <= 43 * MiB && (size_t)DM * DFF * 2 <= WD_STRIDE - WD_W2, "weight map");
static_assert(WS_WD + 2 * WD_STRIDE <= WS_WM && WS_WM + 2 * WM_STRIDE <= WS_XB, "weight map");
static_assert((size_t)TC * INC * 2 <= WS_YAD - WS_Z && (size_t)SLOTS_MAX * DM * 2 <= 136 * MiB && WS_UM + (size_t)SLOTS_MAX * DFE * 2 <= WS_YAD && (size_t)TC * DFF * 2 <= WS_YAD - WS_Z, "z overlays");
static_assert(WS_OM + (size_t)SLOTS_MAX * DM * 2 <= WS_MIX, "om overlay");
constexpr int CW_TMO = 0, CW_BAR = 4096;

constexpr int RING_OFF = 0, RING_BYTES = 131072;
constexpr int LDSCTL_OFF = RING_BYTES, MISC_OFF = LDSCTL_OFF + 320;
constexpr int LDS_BYTES = 147456;

#define RFLF(x) __int_as_float(__builtin_amdgcn_readfirstlane(__float_as_int(x)))
#define GIN(k) ((const float*)(const GAS float*)F.in[k])
struct Frame {
    LAS unsigned char* lds;
    volatile LAS unsigned* MISC;
    gu32* ctl;
    int tid, lane, wave, wave0;
    int vcu, G;
    const float* const __attribute__((address_space(4)))* in;
    float* out; unsigned char* ws;
};
#define DPPI(x, ctrl, rm) __builtin_amdgcn_update_dpp(0, (x), ctrl, rm, 0xF, false)
#define DPPF(x, ctrl, rm) __int_as_float(__builtin_amdgcn_update_dpp(0, __float_as_int(x), ctrl, rm, 0xF, false))
__device__ __forceinline__ float wave_sum_u(float v) {
    v += DPPF(v, 0xB1, 0xF); v += DPPF(v, 0x4E, 0xF); v += DPPF(v, 0x141, 0xF); v += DPPF(v, 0x140, 0xF);
    v += DPPF(v, 0x142, 0xA); v += DPPF(v, 0x143, 0xC);
    return __int_as_float(__builtin_amdgcn_readlane(__float_as_int(v), 63));
}
__device__ __forceinline__ int wave_sum_iu(int v) {
    v += DPPI(v, 0xB1, 0xF); v += DPPI(v, 0x4E, 0xF); v += DPPI(v, 0x141, 0xF); v += DPPI(v, 0x140, 0xF);
    v += DPPI(v, 0x142, 0xA); v += DPPI(v, 0x143, 0xC);
    return __builtin_amdgcn_readlane(v, 63);
}
__device__ __forceinline__ float wave_sum(float v) { return wave_sum_u(v); }
__device__ __forceinline__ int wave_sum_i(int v) { return wave_sum_iu(v); }
__device__ __forceinline__ void relaunder(Frame& F) {
    unsigned ones = ~0u; asm volatile("" : "+s"(ones));
    int t = F.wave0 * 64 + (int)__builtin_amdgcn_mbcnt_hi(ones, __builtin_amdgcn_mbcnt_lo(ones, 0u)); asm volatile("" : "+v"(t)); F.tid = t; F.lane = t & 63; F.wave = __builtin_amdgcn_readfirstlane(t >> 6);
    GAS unsigned char* w = (GAS unsigned char*)F.ws; asm volatile("" : "+s"(w)); F.ws = (unsigned char*)w;
    const float* const __attribute__((address_space(4)))* p = (const float* const __attribute__((address_space(4)))*)__builtin_amdgcn_kernarg_segment_ptr(); asm volatile("" : "+s"(p)); F.in = p;
}
__device__ __forceinline__ void transpose_item(const float* W, int K, int N, bf16* WT, int dst_row, LAS float* scr, int k0, int n0, int lane) {
    float tv[32];
#pragma unroll
    for (int i = 0; i < 32; ++i) tv[i] = W[(size_t)(k0 + 2 * i + (lane >> 5)) * N + n0 + (lane & 31)];
#pragma unroll
    for (int i = 0; i < 32; ++i) scr[(2 * i + (lane >> 5)) * 33 + (lane & 31)] = tv[i];
    LDS_WAIT(); asm volatile("" ::: "memory");
    const int c = lane & 7;
#pragma unroll
    for (int j = 0; j < 4; ++j) { const int n = (lane >> 3) + 8 * j; const LAS float* s = scr + (8 * c) * 33 + n;
        v4u o; o.x = pk2(s[0 * 33], s[1 * 33]); o.y = pk2(s[2 * 33], s[3 * 33]); o.z = pk2(s[4 * 33], s[5 * 33]); o.w = pk2(s[6 * 33], s[7 * 33]);
        *(GAS v4u*)(WT + (size_t)(dst_row + n) * K + k0 + 8 * c) = o; }
    LDS_WAIT(); asm volatile("" ::: "memory");
}
__device__ __forceinline__ void transpose_item8(const float* W, int K, int N, unsigned char* WT, int dst_row, LAS float* scr, int k0, int n0, int lane, float sc) {
    float tv[32];
#pragma unroll
    for (int i = 0; i < 32; ++i) tv[i] = W[(size_t)(k0 + 2 * i + (lane >> 5)) * N + n0 + (lane & 31)];
#pragma unroll
    for (int i = 0; i < 32; ++i) scr[(2 * i + (lane >> 5)) * 33 + (lane & 31)] = tv[i];
    LDS_WAIT(); asm volatile("" ::: "memory");
    const int n = lane & 31, hf = lane >> 5; const LAS float* s = scr + (32 * hf) * 33 + n;
    v4u o[2];
#pragma unroll
    for (int q = 0; q < 8; ++q) { unsigned w = 0;
        w = __builtin_amdgcn_cvt_pk_fp8_f32(s[(4 * q + 0) * 33] * sc, s[(4 * q + 1) * 33] * sc, w, false);
        w = __builtin_amdgcn_cvt_pk_fp8_f32(s[(4 * q + 2) * 33] * sc, s[(4 * q + 3) * 33] * sc, w, true);
        o[q >> 2][q & 3] = w; }
    GAS v4u* dp = (GAS v4u*)(WT + (size_t)(dst_row + n) * K + k0 + 32 * hf);
    dp[0] = o[0]; dp[1] = o[1];
    LDS_WAIT(); asm volatile("" ::: "memory");
}
template <int MODE>
__device__ __forceinline__ void prep_matrix(Frame& F, const float* W, int K, int N, bf16* WT, int row_off, LAS float* scr, int& ibase, int NC = 0) {
    const int nblk = (NC ? NC : N) / 32, nitems = (K / 64) * nblk;
    const int gw = F.vcu * NWAVES + F.wave, NGW = F.G * NWAVES;
    const int first = (gw - (ibase % NGW) + NGW) % NGW;
    for (int it = first; it < nitems; it += NGW) { const int kb = it / nblk, nb = it - kb * nblk, n0 = nb * 32;
        const int dst = (MODE & 1) ? row_off + (n0 >> 7) * 256 + (n0 & 127) : row_off + n0;
        if (MODE & 2) transpose_item8(W, K, N, (unsigned char*)WT, dst, scr, kb * 64, n0, F.lane, W8_SCALE);
        else transpose_item(W, K, N, WT, dst, scr, kb * 64, n0, F.lane); }
    ibase += nitems;
}
__device__ __forceinline__ void prep_matrix8p(Frame& F, const float* W, int K, int N, unsigned char* WT, int pitch, LAS float* scr, int& ibase) {
    const int nblk = N / 32, nitems = (K / 64) * nblk;
    const int gw = F.vcu * NWAVES + F.wave, NGW = F.G * NWAVES;
    const int first = (gw - (ibase % NGW) + NGW) % NGW;
    for (int it = first; it < nitems; it += NGW) { const int kb = it / nblk, nb = it - kb * nblk, n0 = nb * 32;
        transpose_item8(W, pitch, N, WT, n0, scr, kb * 64, n0, F.lane, W8_SCALE); }
    ibase += nitems;
}
__device__ __forceinline__ void p0_weights(Frame& F) {
    LAS float* scr = (LAS float*)(F.lds + RING_OFF + F.wave * 16384);
    int ib = 0;
    for (int l = 0; l < DEPTH; ++l) {
        unsigned char* wl = F.ws + WS_WL + (size_t)l * WL_STRIDE;
#if FP8_INPROJ_GATES
        prep_matrix<0>(F, GIN(4) + (size_t)l * DM * INC, DM, INC, (bf16*)(wl + WL_WIN), 0, scr, ib, ZGA);
        prep_matrix<2>(F, GIN(4) + (size_t)l * DM * INC + ZGA, DM, INC, (bf16*)(wl + WL_WIN + WL_WING8), 0, scr, ib, INC - ZGA);
#elif FP8_INPROJ_QKV
        prep_matrix<2>(F, GIN(4) + (size_t)l * DM * INC, DM, INC, (bf16*)(wl + WL_WIN), 0, scr, ib, ZGA);
        prep_matrix<0>(F, GIN(4) + (size_t)l * DM * INC + ZGA, DM, INC, (bf16*)(wl + WL_WIN + WL_WING), 0, scr, ib, INC - ZGA);
#else
        prep_matrix<0>(F, GIN(4) + (size_t)l * DM * INC, DM, INC, (bf16*)(wl + WL_WIN), 0, scr, ib);
#endif
        prep_matrix<0>(F, GIN(11) + (size_t)l * 1024 * DM, 1024, DM, (bf16*)(wl + WL_WPAD), 0, scr, ib);
        prep_matrix<0>(F, GIN(12) + (size_t)l * 1024 * DM, 1024, DM, (bf16*)(wl + WL_WPAD), 2048, scr, ib);
        prep_matrix<0>(F, GIN(13) + (size_t)l * DM * DM, DM, DM, (bf16*)(wl + WL_WO), 0, scr, ib);
    }
    for (int i = 0; i < 2; ++i) {
        unsigned char* wd = F.ws + WS_WD + (size_t)i * WD_STRIDE;
        prep_matrix<FP8_DENSE_UP ? 3 : 1>(F, GIN(18) + (size_t)i * DM * DFF, DM, DFF, (bf16*)(wd + WD_W13), 0, scr, ib);
        prep_matrix<FP8_DENSE_UP ? 3 : 1>(F, GIN(19) + (size_t)i * DM * DFF, DM, DFF, (bf16*)(wd + WD_W13), 128, scr, ib);
#if FP8_DENSE_DOWN
        prep_matrix8p(F, GIN(20) + (size_t)i * DFF * DM, DFF, DM, wd + WD_W2, DFF8, scr, ib);
#else
        prep_matrix<0>(F, GIN(20) + (size_t)i * DFF * DM, DFF, DM, (bf16*)(wd + WD_W2), 0, scr, ib);
#endif
        unsigned char* wm = F.ws + WS_WM + (size_t)i * WM_STRIDE;
        for (int e = 0; e < NEXP; ++e) {
            prep_matrix<FP8_MOE_UP ? 3 : 1>(F, GIN(22) + ((size_t)i * NEXP + e) * DM * DFE, DM, DFE, (bf16*)(wm + WM_W13), e * 2048, scr, ib);
            prep_matrix<FP8_MOE_UP ? 3 : 1>(F, GIN(23) + ((size_t)i * NEXP + e) * DM * DFE, DM, DFE, (bf16*)(wm + WM_W13), e * 2048 + 128, scr, ib);
            prep_matrix<FP8_MOE_DOWN ? 2 : 0>(F, GIN(24) + ((size_t)i * NEXP + e) * DFE * DM, DFE, DM, (bf16*)(wm + WM_W2), e * 2048, scr, ib);
        }
    }
#if FP8_DENSE_DOWN
    {
        const int gt = (F.vcu * NWAVES + F.wave) * 64 + F.lane, NGT = F.G * NWAVES * 64; const v4u z = {0u, 0u, 0u, 0u};
        for (int idx = gt; idx < (TC + 2 * DM) * 8; idx += NGT) { const int r = idx >> 3, c = idx & 7;
            unsigned char* rowp = r < TC ? F.ws + WS_U8 + (size_t)r * DFF8 : F.ws + WS_WD + (size_t)((r - TC) / DM) * WD_STRIDE + WD_W2 + (size_t)((r - TC) % DM) * DFF8;
            *(GAS v4u*)(rowp + DFF + 16 * c) = z; }
    }
#endif
}
typedef float f32x2_ __attribute__((ext_vector_type(2)));
__device__ __forceinline__ void unpack8(f32x4& a, f32x4& b, v4u w) { a[0] = pg8::bf_lo(w.x); a[1] = pg8::bf_hi(w.x); a[2] = pg8::bf_lo(w.y); a[3] = pg8::bf_hi(w.y); b[0] = pg8::bf_lo(w.z); b[1] = pg8::bf_hi(w.z); b[2] = pg8::bf_lo(w.w); b[3] = pg8::bf_hi(w.w); }
template <bool ROUTE>
__device__ __forceinline__ void ln_row(Frame& F, f32x4 (&v)[8], const LAS float* gl, const LAS float* bl, const LAS float* rt, float* dst, bf16* xb, unsigned char* xlo, unsigned char* xb8, bool last, int row, int (&cnt)[8]) {
    float s = 0.f;
#pragma unroll
    for (int j = 0; j < 8; ++j) s += (v[j][0] + v[j][1]) + (v[j][2] + v[j][3]);
    const float mean = wave_sum_u(s) * (1.f / DM); float s2 = 0.f;
#pragma unroll
    for (int j = 0; j < 8; ++j) { v[j] = v[j] - mean; s2 += (v[j][0] * v[j][0] + v[j][1] * v[j][1]) + (v[j][2] * v[j][2] + v[j][3] * v[j][3]); }
    const float rstd = 1.f / sqrtf(wave_sum_u(s2) * (1.f / DM) + LN_EPS);
#pragma unroll
    for (int j = 0; j < 8; ++j) { const f32x4 g = *(const LAS f32x4*)(gl + (j * 64 + F.lane) * 4), b = *(const LAS f32x4*)(bl + (j * 64 + F.lane) * 4); v[j] = v[j] * rstd * g + b; }
    if (last) {
#pragma unroll
        for (int j = 0; j < 4; ++j) { *(f32x4*)(dst + 8 * F.lane + 512 * j) = v[2 * j]; *(f32x4*)(dst + 8 * F.lane + 512 * j + 4) = v[2 * j + 1]; }
    } else {
#pragma unroll
        for (int j = 0; j < 4; ++j) { v4u w, wl; const f32x4 a = v[2 * j], b = v[2 * j + 1];
            w.x = pg8::cvt_pk_bf16(a[0], a[1]); w.y = pg8::cvt_pk_bf16(a[2], a[3]); w.z = pg8::cvt_pk_bf16(b[0], b[1]); w.w = pg8::cvt_pk_bf16(b[2], b[3]);
            unsigned t0 = 0, t1 = 0;
            t0 = __builtin_amdgcn_cvt_pk_fp8_f32((a[0] - pg8::bf_lo(w.x)) * LO8_SCALE, (a[1] - pg8::bf_hi(w.x)) * LO8_SCALE, t0, false); t0 = __builtin_amdgcn_cvt_pk_fp8_f32((a[2] - pg8::bf_lo(w.y)) * LO8_SCALE, (a[3] - pg8::bf_hi(w.y)) * LO8_SCALE, t0, true);
            t1 = __builtin_amdgcn_cvt_pk_fp8_f32((b[0] - pg8::bf_lo(w.z)) * LO8_SCALE, (b[1] - pg8::bf_hi(w.z)) * LO8_SCALE, t1, false); t1 = __builtin_amdgcn_cvt_pk_fp8_f32((b[2] - pg8::bf_lo(w.w)) * LO8_SCALE, (b[3] - pg8::bf_hi(w.w)) * LO8_SCALE, t1, true);
            uint2 wl8; wl8.x = t0; wl8.y = t1; (void)wl;
            *(v4u*)(xb + 8 * F.lane + 512 * j) = w; *(uint2*)((unsigned char*)xlo + 8 * F.lane + 512 * j) = wl8; } }
    if (xb8) {
#pragma unroll
        for (int j = 0; j < 4; ++j) { uint2 w8; const f32x4 a = v[2 * j], b = v[2 * j + 1]; unsigned t = 0;
            t = __builtin_amdgcn_cvt_pk_fp8_f32(a[0], a[1], t, false); t = __builtin_amdgcn_cvt_pk_fp8_f32(a[2], a[3], t, true); w8.x = t;
            t = __builtin_amdgcn_cvt_pk_fp8_f32(b[0], b[1], t, false); t = __builtin_amdgcn_cvt_pk_fp8_f32(b[2], b[3], t, true); w8.y = t;
            *(uint2*)(xb8 + 8 * F.lane + 512 * j) = w8; } }
    if (ROUTE) {
        float lg[8];
#pragma unroll
        for (int e = 0; e < 8; ++e) { float a = 0.f;
#pragma unroll
            for (int j = 0; j < 8; ++j) { const f32x4 w = *(const LAS f32x4*)(rt + e * DM + (j * 64 + F.lane) * 4); a += (v[j][0] * w[0] + v[j][1] * w[1]) + (v[j][2] * w[2] + v[j][3] * w[3]); }
            lg[e] = wave_sum_u(a); }
        float v1 = -INFINITY; int e1 = 0;
#pragma unroll
        for (int e = 0; e < 8; ++e) if (lg[e] > v1) { v1 = lg[e]; e1 = e; }
        float v2 = -INFINITY; int e2 = 0;
#pragma unroll
        for (int e = 0; e < 8; ++e) if (e != e1 && lg[e] > v2) { v2 = lg[e]; e2 = e; }
        const float g1 = 1.f / (1.f + expf(v2 - v1)), g2 = 1.f - g1;
#pragma unroll
        for (int e = 0; e < 8; ++e) cnt[e] += (e == e1) + (e == e2);
        if (F.lane == 0) { int4 r; r.x = e1; r.y = e2; r.z = __float_as_int(g1); r.w = __float_as_int(g2); *(int4*)(F.ws + WS_ROUTE + (size_t)row * 16) = r; }
    }
}
template <int MODE, bool ROUTE>
__device__ __forceinline__ void ln_phase(Frame& F, int chunk, const float* gsrc, const float* bsrc, const float* router, bool last, bool want8 = false) {
    LAS float* rt = (LAS float*)(F.lds);
    LAS int* wcnt = (LAS int*)(F.lds + 65536);
    LAS float* gl = (LAS float*)(F.lds + 69632); LAS float* bl = gl + DM;
#define LNPOS(d) (((2 * ((d) >> 9) + (((d) >> 2) & 1)) * 64 + (((d) >> 3) & 63)) * 4 + ((d) & 3))
    for (int idx = F.tid; idx < DM; idx += NWAVES * 64) { gl[LNPOS(idx)] = gsrc[idx]; bl[LNPOS(idx)] = bsrc[idx]; }
    if (ROUTE) { float rv[32];
#pragma unroll
        for (int q = 0; q < 32; ++q) rv[q] = router[F.tid + q * (NWAVES * 64)];
#pragma unroll
        for (int q = 0; q < 32; ++q) { const int idx = F.tid + q * (NWAVES * 64), d = idx >> 3; rt[(idx & 7) * DM + LNPOS(d)] = rv[q]; } }
#undef LNPOS
    __syncthreads();
    bf16* XB = (bf16*)(F.ws + WS_XB); unsigned char* XLO = F.ws + WS_XLO; unsigned char* XB8 = F.ws + WS_XB8;
    const bf16* MIX = (const bf16*)(F.ws + WS_MIX);
    const bf16* OM = (const bf16*)(F.ws + WS_OM);
#define LD16(p, j) (*(const v4u*)((p) + 8 * F.lane + 512 * (j)))
    for (int seg = F.vcu; seg < NSEG; seg += F.G) {
        int cnt[8];
#pragma unroll
        for (int e = 0; e < 8; ++e) cnt[e] = 0;
        for (int i = 0; i < 8; i += 2) {
            const int rowA = SEGROW(seg, F.wave, i), rowB = rowA + 1; const size_t growA = (size_t)chunk * TC + rowA, growB = growA + 1;
            f32x4 va[8], vb[8];
            if (MODE == 0) {
                const float* srcA = growA < (size_t)TPROMPT ? GIN(0) + growA * DM : GIN(1) + (growA - TPROMPT) * DM; const float* srcB = srcA + DM;
#pragma unroll
                for (int j = 0; j < 4; ++j) { va[2 * j] = *(const f32x4*)(srcA + 8 * F.lane + 512 * j); va[2 * j + 1] = *(const f32x4*)(srcA + 8 * F.lane + 512 * j + 4);
                    vb[2 * j] = *(const f32x4*)(srcB + 8 * F.lane + 512 * j); vb[2 * j + 1] = *(const f32x4*)(srcB + 8 * F.lane + 512 * j + 4); }
                __builtin_amdgcn_sched_barrier(0);
            } else {
                const bf16* hA = XB + (size_t)rowA * DM; const bf16* hB = hA + DM; const unsigned char* lA = XLO + (size_t)rowA * DM; const unsigned char* lB = lA + DM;
                v4u ha[4], hb[4], wa[4], wb[4]; uint2 la[4], lb[4];
#define LD8B(p, j) (*(const uint2*)((p) + 8 * F.lane + 512 * (j)))
#define UNLO(a, b, w) do { const f32x2_ q0 = __builtin_amdgcn_cvt_pk_f32_fp8((int)(w).x, false), q1 = __builtin_amdgcn_cvt_pk_f32_fp8((int)(w).x, true), q2 = __builtin_amdgcn_cvt_pk_f32_fp8((int)(w).y, false), q3 = __builtin_amdgcn_cvt_pk_f32_fp8((int)(w).y, true); \
    a[0] = q0.x * (1.f / LO8_SCALE); a[1] = q0.y * (1.f / LO8_SCALE); a[2] = q1.x * (1.f / LO8_SCALE); a[3] = q1.y * (1.f / LO8_SCALE); b[0] = q2.x * (1.f / LO8_SCALE); b[1] = q2.y * (1.f / LO8_SCALE); b[2] = q3.x * (1.f / LO8_SCALE); b[3] = q3.y * (1.f / LO8_SCALE); } while (0)
                if (MODE == 1 || MODE == 2) {
                    const bf16* mA = MIX + (size_t)rowA * DM; const bf16* mB = mA + DM;
#pragma unroll
                    for (int j = 0; j < 4; ++j) { ha[j] = LD16(hA, j); la[j] = LD8B(lA, j); wa[j] = LD16(mA, j); hb[j] = LD16(hB, j); lb[j] = LD8B(lB, j); wb[j] = LD16(mB, j); }
                    __builtin_amdgcn_sched_barrier(0);
#pragma unroll
                    for (int j = 0; j < 4; ++j) { f32x4 h0, h1, l0, l1, m0, m1;
                        unpack8(h0, h1, ha[j]); UNLO(l0, l1, la[j]); unpack8(m0, m1, wa[j]); va[2 * j] = (h0 + l0) * ALPHA + m0; va[2 * j + 1] = (h1 + l1) * ALPHA + m1;
                        unpack8(h0, h1, hb[j]); UNLO(l0, l1, lb[j]); unpack8(m0, m1, wb[j]); vb[2 * j] = (h0 + l0) * ALPHA + m0; vb[2 * j + 1] = (h1 + l1) * ALPHA + m1; }
                } else {
                    const int4 ts = *(const int4*)(F.ws + WS_TOKSLOT + (size_t)rowA * 8);
                    const bf16* a1 = OM + (size_t)ts.x * DM; const bf16* a2 = OM + (size_t)ts.y * DM; const bf16* b1 = OM + (size_t)ts.z * DM; const bf16* b2 = OM + (size_t)ts.w * DM;
                    v4u wa2[4], wb2[4];
#pragma unroll
                    for (int j = 0; j < 4; ++j) { ha[j] = LD16(hA, j); la[j] = LD8B(lA, j); wa[j] = LD16(a1, j); wa2[j] = LD16(a2, j); hb[j] = LD16(hB, j); lb[j] = LD8B(lB, j); wb[j] = LD16(b1, j); wb2[j] = LD16(b2, j); }
                    __builtin_amdgcn_sched_barrier(0);
#pragma unroll
                    for (int j = 0; j < 4; ++j) { f32x4 h0, h1, l0, l1, m0, m1, n0, n1;
                        unpack8(h0, h1, ha[j]); UNLO(l0, l1, la[j]); unpack8(m0, m1, wa[j]); unpack8(n0, n1, wa2[j]); va[2 * j] = (h0 + l0) * ALPHA + (m0 + n0); va[2 * j + 1] = (h1 + l1) * ALPHA + (m1 + n1);
                        unpack8(h0, h1, hb[j]); UNLO(l0, l1, lb[j]); unpack8(m0, m1, wb[j]); unpack8(n0, n1, wb2[j]); vb[2 * j] = (h0 + l0) * ALPHA + (m0 + n0); vb[2 * j + 1] = (h1 + l1) * ALPHA + (m1 + n1); }
                }
            }
            ln_row<ROUTE>(F, va, gl, bl, rt, F.out + growA * DM, XB + (size_t)rowA * DM, XLO + (size_t)rowA * DM, want8 ? XB8 + (size_t)rowA * DM : nullptr, last, rowA, cnt);
            ln_row<ROUTE>(F, vb, gl, bl, rt, F.out + growB * DM, XB + (size_t)rowB * DM, XLO + (size_t)rowB * DM, want8 ? XB8 + (size_t)rowB * DM : nullptr, last, rowB, cnt);
        }
        if (ROUTE) {
            if (F.lane == 0) {
#pragma unroll
                for (int e = 0; e < 8; ++e) wcnt[F.wave * 8 + e] = cnt[e]; }
            __syncthreads();
            if (F.tid < 8) { int t = 0;
#pragma unroll
                for (int w = 0; w < 8; ++w) t += wcnt[w * 8 + F.tid];
                *(int*)(F.ws + WS_SEGCNT + ((size_t)seg * 8 + F.tid) * 4) = t; }
            __syncthreads();
        }
    }
#undef LD16
#undef LD8B
#undef UNLO
    __syncthreads();
}
__device__ __forceinline__ void moe_assign_phase(Frame& F) {
    LAS int* sc = (LAS int*)(F.lds);
    LAS int* tot = sc + NSEG * 8; LAS int* pre = tot + 8; LAS int* off = pre + 8; LAS int* e1s = off + 16; LAS int* e2s = e1s + 64; LAS int* sl1 = e2s + 64; LAS int* sl2 = sl1 + 64;
    const bf16* XB = (const bf16*)(F.ws + WS_XB); bf16* HBG = (bf16*)(F.ws + WS_HBG);
    for (int seg = F.vcu; seg < NSEG; seg += F.G) {
        for (int idx = F.tid; idx < NSEG * 8; idx += NWAVES * 64) sc[idx] = *(const int*)(F.ws + WS_SEGCNT + (size_t)idx * 4);
        int4 r = {0, 0, 0, 0};
        if (F.tid < 64) { r = *(const int4*)(F.ws + WS_ROUTE + (size_t)SEGROW(seg, F.tid >> 3, F.tid & 7) * 16); e1s[F.tid] = r.x; e2s[F.tid] = r.y; }
        __syncthreads();
        { const int e = F.wave; int t = 0, p = 0;
#pragma unroll
          for (int i = 0; i < NSEG / 64; ++i) { const int s2 = F.lane * (NSEG / 64) + i; const int c = sc[s2 * 8 + e]; t += c; p += (s2 < seg) ? c : 0; }
          t = wave_sum_i(t); p = wave_sum_i(p); if (F.lane == 0) { tot[e] = t; pre[e] = p; } }
        __syncthreads();
        if (F.tid == 0) { int o = 0;
            for (int e = 0; e < 8; ++e) { off[e] = o; o += (tot[e] + 255) & ~255; }
            off[8] = o;
            if (seg == 0) { for (int e = 0; e <= 8; ++e) *(int*)(F.ws + WS_MOEOFF + e * 4) = off[e]; } }
        __syncthreads();
        if (F.tid < 64) { const int e1 = r.x, e2 = r.y; int r1 = 0, r2 = 0;
            for (int t2 = 0; t2 < F.tid; ++t2) { const int a = e1s[t2], b = e2s[t2]; r1 += (a == e1) + (b == e1); r2 += (a == e2) + (b == e2); }
            const int s1 = off[e1] + pre[e1] + r1, s2 = off[e2] + pre[e2] + r2;
            int2 ts; ts.x = s1; ts.y = s2; *(int2*)(F.ws + WS_TOKSLOT + (size_t)SEGROW(seg, F.tid >> 3, F.tid & 7) * 8) = ts;
            *(int*)(F.ws + WS_SLOTGATE + (size_t)s1 * 4) = r.z; *(int*)(F.ws + WS_SLOTGATE + (size_t)s2 * 4) = r.w;
            sl1[F.tid] = s1; sl2[F.tid] = s2; }
        __syncthreads();
#pragma unroll 8
        for (int q = F.wave * 16; q < F.wave * 16 + 16; ++q) { const int tok = q >> 1; const int slot = (q & 1) ? sl2[tok] : sl1[tok];
#if FP8_MOE_UP
            const v4u* src = (const v4u*)(F.ws + WS_XB8 + (size_t)SEGROW(seg, tok >> 3, tok & 7) * DM); v4u* dst = (v4u*)((unsigned char*)HBG + (size_t)slot * DM);
            const v4u t0 = src[F.lane], t1 = src[F.lane + 64]; dst[F.lane] = t0; dst[F.lane + 64] = t1; }
#else
            const v4u* src = (const v4u*)(XB + (size_t)SEGROW(seg, tok >> 3, tok & 7) * DM); v4u* dst = (v4u*)(HBG + (size_t)slot * DM);
#pragma unroll
            for (int i = 0; i < 4; ++i) dst[F.lane + 64 * i] = src[F.lane + 64 * i]; }
#endif
        __syncthreads();
    }
}
__device__ __forceinline__ void combine_phase(Frame& F, int l) {
    asm volatile("" : "+s"(l));
    const float* lq1 = GIN(6) + l * 128; const float* lk1 = GIN(7) + l * 128; const float* lq2 = GIN(8) + l * 128; const float* lk2 = GIN(9) + l * 128;
    const float d1 = wave_sum(lq1[F.lane] * lk1[F.lane] + lq1[F.lane + 64] * lk1[F.lane + 64]);
    const float d2 = wave_sum(lq2[F.lane] * lk2[F.lane] + lq2[F.lane + 64] * lk2[F.lane + 64]);
    const float linit = l == 0 ? 0.2f : l == 1 ? 0.35550906759096926f : l == 2 ? 0.4707130183435842f : 0.5560582041556405f;
    const float lam = expf(d1) - expf(d2) + linit;
    const f32x4 g4 = *(const f32x4*)(GIN(10) + l * 256 + 4 * F.lane);
    const float* OD = (const float*)(F.ws + WS_ODIFF); bf16* YD = (bf16*)(F.ws + WS_YAD) + (size_t)TC * 1024;
    const int gw = F.vcu * NWAVES + F.wave, NGW = F.G * NWAVES;
    for (int row = gw; row < TC; row += NGW) {
#pragma unroll
        for (int h = 0; h < 4; ++h) {
            const f32x4 a = *(const f32x4*)(OD + (size_t)row * 2048 + (2 * h) * 256 + 4 * F.lane);
            const f32x4 b = *(const f32x4*)(OD + (size_t)row * 2048 + (2 * h + 1) * 256 + 4 * F.lane);
            const f32x4 d = a - b * lam;
            const float ss = wave_sum((d[0] * d[0] + d[1] * d[1]) + (d[2] * d[2] + d[3] * d[3]));
            const float rs = (1.f / sqrtf(ss * (1.f / 256.f) + LN_EPS)) * (1.f - linit);
            const f32x4 y = d * rs * g4;
            uint2 w; w.x = pg8::cvt_pk_bf16(y[0], y[1]); w.y = pg8::cvt_pk_bf16(y[2], y[3]);
            *(uint2*)(YD + (size_t)row * 1024 + h * 256 + 4 * F.lane) = w;
        }
    }
}
__device__ __forceinline__ void attn_phase(Frame& F, int l, char* lds) {
    asm volatile("" : "+s"(l));
    const att::bf16* Z = (const att::bf16*)(F.ws + WS_Z);
    att::bf16* YA = (att::bf16*)(F.ws + WS_YAD); att::bf16* YD = YA + (size_t)TC * 1024;
    const float* lq1 = GIN(6) + l * 128; const float* lk1 = GIN(7) + l * 128; const float* lq2 = GIN(8) + l * 128; const float* lk2 = GIN(9) + l * 128;
    const float d1 = wave_sum(lq1[F.lane] * lk1[F.lane] + lq1[F.lane + 64] * lk1[F.lane + 64]);
    const float d2 = wave_sum(lq2[F.lane] * lk2[F.lane] + lq2[F.lane + 64] * lk2[F.lane + 64]);
    const float linit = l == 0 ? 0.2f : l == 1 ? 0.35550906759096926f : l == 2 ? 0.4707130183435842f : 0.5560582041556405f;
    const float lam = __int_as_float(__builtin_amdgcn_readfirstlane(__float_as_int(expf(d1) - expf(d2) + linit)));
    float* Scr = (float*)(F.ws + WS_ODIFF) + (size_t)blockIdx.x * (256 * 256);
#ifndef ATT_DIFF_REPS
#define ATT_DIFF_REPS 1
#endif
#ifndef ATT_WIN_REPS
#define ATT_WIN_REPS 1
#endif
    for (int rep = 0; rep < ATT_DIFF_REPS; ++rep)
    for (int u = F.vcu; u < CSEQ * 4 * 8; u += F.G) {
        const int qb = u & 7, h = (u >> 3) & 3, b = u >> 5;
        const size_t row0 = (size_t)b * SEQ;
        const att::bf16* V = Z + row0 * INC + ZVD + h * 256;
        const float slope = exp2f(-8.0f * (float)(9 + h) / 12.0f);
        att::attn_diff_body<false>(Z + (row0 + qb * 256) * INC + ZQD + (h * 2 + 0) * 128, Z + row0 * INC + ZKD + (h * 2 + 0) * 128, V, Scr, nullptr, 0, lds, qb * 256, RFLF(-slope * att::LOG2E), 0.f, 0.f, nullptr, SEQ, F.wave0);
        att::attn_diff_body<true>(Z + (row0 + qb * 256) * INC + ZQD + (h * 2 + 1) * 128, Z + row0 * INC + ZKD + (h * 2 + 1) * 128, V, Scr, YD + (row0 + qb * 256) * 1024 + h * 256, 1024, lds, qb * 256, RFLF(-slope * att::LOG2E), lam, RFLF(1.f - linit), GIN(10) + l * 256, SEQ, F.wave0);
    }
    for (int rep = 0; rep < ATT_WIN_REPS; ++rep)
    for (int i = 0;; ++i) {
        const int u = i * F.G + F.vcu; if (u >= CSEQ * 8 * 8) break;
        const int qb = u & 7, hq = (u >> 3) & 7, b = u >> 6, g = hq >> 2;
        const size_t row0 = (size_t)b * SEQ;
        const int klo = qb * 256 - 128 < 0 ? 0 : qb * 256 - 128, khi = qb * 256 + 384 > SEQ ? SEQ : qb * 256 + 384;
        const att::bf16* Q = Z + (row0 + qb * 256) * INC + ZQA + hq * 128;
        const att::bf16* K = Z + (row0 + klo) * INC + ZKA + g * 128;
        const att::bf16* V = Z + (row0 + klo) * INC + ZVA + g * 128;
        att::bf16* O = YA + (row0 + qb * 256) * 1024 + hq * 128;
        const float slope = exp2f(-8.0f * (float)(1 + hq) / 12.0f);
        const float sink = GIN(5)[l * 8 + hq];
        att::attn_win_body(Q, K, V, O, 1024, lds, qb * 256 - klo, RFLF(-slope * att::LOG2E), RFLF(sink * att::LOG2E), khi - klo, F.wave0);
    }
}

struct Args { const float* in[25]; float* out; unsigned char* ws; int lo, hi; };
__global__ void __launch_bounds__(NWAVES * 64, 2) mk_fwd(Args args) {
    extern __shared__ __attribute__((aligned(16))) unsigned char lds[];
    Frame F;
    F.lds = (LAS unsigned char*)lds;
    F.MISC = (volatile LAS unsigned*)(F.lds + MISC_OFF);
    F.tid = threadIdx.x; F.lane = F.tid & 63; F.wave = __builtin_amdgcn_readfirstlane(F.tid >> 6); F.wave0 = F.wave;
    F.G = gridDim.x; { const int bx = blockIdx.x; F.vcu = (F.G % 8 == 0) ? (bx % 8) * (F.G / 8) + bx / 8 : bx; }
    F.in = (const float* const __attribute__((address_space(4)))*)__builtin_amdgcn_kernarg_segment_ptr(); F.out = args.out; F.ws = args.ws;
    F.ctl = (gu32*)(args.ws + WS_CTL);
    for (int u = F.tid; u < (LDS_BYTES - LDSCTL_OFF) / 4; u += NWAVES * 64) ((LAS unsigned*)(F.lds + LDSCTL_OFF))[u] = 0u;
    __syncthreads();
    const int lo = args.lo, hi = args.hi;
    const bool use_bar = (hi - lo) > 1;
    XcdBarrier bar; bar.bar = (unsigned*)(F.ctl + CW_BAR); bar.x = 0; bar.st = nullptr;
    if (use_bar) bar = xcd_barrier_post((unsigned*)(F.ctl + CW_BAR), F.MISC + 8);
#define IN(g) (lo <= (g) && (g) < hi)
#define SEAM(g) do { if ((g) + 1 < hi) xcd_barrier(bar); } while (0)
    typedef pg8::bf16_t pbf;

    if (IN(0)) { relaunder(F); p0_weights(F);
#if defined(PROBE_DUP_P0)
        xcd_barrier(bar); p0_weights(F);
#endif
        SEAM(0); }

    for (int chunk = 0; chunk < NCHUNK; ++chunk)
    for (int l = 0; l < DEPTH; ++l) {
        const int g0 = 1 + (chunk * DEPTH + l) * NPH;
        const bool moe = (l & 1) != 0; const int fi = l >> 1;
#ifndef LN0_REPS
#define LN0_REPS 1
#endif
        if (l == 0 && IN(g0 + 0)) { relaunder(F); for (int rep = 0; rep < LN0_REPS; ++rep) ln_phase<0, false>(F, chunk, GIN(2), GIN(3), nullptr, false, (FP8_INPROJ_QKV | FP8_INPROJ_GATES) != 0);
#if defined(PROBE_DUP_LN0)
            xcd_barrier(bar); ln_phase<0, false>(F, chunk, GIN(2), GIN(3), nullptr, false, (FP8_INPROJ_QKV | FP8_INPROJ_GATES) != 0);
#endif
            SEAM(g0 + 0); }
        if (IN(g0 + 1)) {
            relaunder(F); unsigned char* ws = F.ws; unsigned char* wl = ws + WS_WL + (size_t)l * WL_STRIDE; unsigned char* wd = ws + WS_WD + (size_t)fi * WD_STRIDE; unsigned char* wm = ws + WS_WM + (size_t)fi * WM_STRIDE; (void)wl; (void)wd; (void)wm;
#if FP8_INPROJ_GATES
            { pg8::Gemm g{(const pbf*)(ws + WS_XB), (const pbf*)(wl + WL_WIN), TC, ZGA, DM}; pg8::StaticOrder S; S.init(TC, ZGA, F.G, (int)blockIdx.x);
              pg8::EpiPlain E{(pbf*)(ws + WS_Z), INC, 0x7fffffff, 0x7fffffff, 0x3CFu, att::CS, 1.0f};
              pg8::gemm_phase<pg8::EpiPlain, pg8::StaticOrder, PG8_ALIGN, PG8_SP2>(F.lds + RING_OFF, g, S, E, F.tid); }
            { pg8::Gemm g{(const pbf*)(ws + WS_XB8), (const pbf*)(wl + WL_WIN + WL_WING8), TC, INC - ZGA, DM / 2};
              pg8::UnevenOrder S; S.init(TC, INC - ZGA, F.G, (int)blockIdx.x, (TC / 256) * (ZGA / 256), 3, 5);
              pg8::EpiPlain E{(pbf*)(ws + WS_Z) + ZGA, INC, 0x7fffffff, 0, 0u, 1.0f, 1.0f / W8_SCALE};
              pg8::gemm_phase<pg8::EpiPlain, pg8::UnevenOrder, PG8_ALIGN, PG8_SP2, true>(F.lds + RING_OFF, g, S, E, F.tid); }
#elif FP8_INPROJ_QKV
            { pg8::Gemm g{(const pbf*)(ws + WS_XB8), (const pbf*)(wl + WL_WIN), TC, ZGA, DM / 2}; pg8::StaticOrder S; S.init(TC, ZGA, F.G, (int)blockIdx.x);
              pg8::EpiPlain E{(pbf*)(ws + WS_Z), INC, 0x7fffffff, 0x7fffffff, 0x3CFu, att::CS, 1.0f / W8_SCALE};
              pg8::gemm_phase<pg8::EpiPlain, pg8::StaticOrder, PG8_ALIGN, PG8_SP2, true>(F.lds + RING_OFF, g, S, E, F.tid); }
            { pg8::Gemm g{(const pbf*)(ws + WS_XB), (const pbf*)(wl + WL_WIN + WL_WING), TC, INC - ZGA, DM}; pg8::StaticOrder S; S.init(TC, INC - ZGA, F.G, (int)blockIdx.x);
              pg8::EpiPlain E{(pbf*)(ws + WS_Z) + ZGA, INC, 0x7fffffff, 0, 0u, 1.0f, 1.0f};
              pg8::gemm_phase<pg8::EpiPlain, pg8::StaticOrder, PG8_ALIGN, PG8_SP2>(F.lds + RING_OFF, g, S, E, F.tid); }
#else
            pg8::Gemm g{(const pbf*)(ws + WS_XB), (const pbf*)(wl + WL_WIN), TC, INC, DM}; pg8::StaticOrder S; S.init(TC, INC, F.G, (int)blockIdx.x);
            pg8::EpiPlain E{(pbf*)(ws + WS_Z), INC, 0x7fffffff, ZGA / 256, 0x3CFu, att::CS, 1.0f};
            pg8::gemm_phase<pg8::EpiPlain, pg8::StaticOrder, PG8_ALIGN, PG8_SP2>(F.lds + RING_OFF, g, S, E, F.tid);
#endif
            SEAM(g0 + 1);
        }
        if (IN(g0 + 2)) { relaunder(F); attn_phase(F, l, (char*)lds + RING_OFF);
#if defined(PROBE_DUP_ATT)
            xcd_barrier(bar); attn_phase(F, l, (char*)lds + RING_OFF);
#endif
            SEAM(g0 + 2); }
        if (IN(g0 + 4)) {
            relaunder(F); unsigned char* ws = F.ws; unsigned char* wl = ws + WS_WL + (size_t)l * WL_STRIDE; unsigned char* wd = ws + WS_WD + (size_t)fi * WD_STRIDE; unsigned char* wm = ws + WS_WM + (size_t)fi * WM_STRIDE; (void)wl; (void)wd; (void)wm;
            pg8::Gemm g{(const pbf*)(ws + WS_YAD), (const pbf*)(wl + WL_WPAD), 2 * TC, 4096, 1024}; pg8::PairOrder S; S.init(TC, F.G, (int)blockIdx.x);
            pg8::EpiGate E{(const pbf*)(ws + WS_Z) + ZGA, INC, (pbf*)(ws + WS_MERGED), DM, TC / 256};
            pg8::gemm_phase<pg8::EpiGate, pg8::PairOrder, PG8_ALIGN, PG8_SP2>(F.lds + RING_OFF, g, S, E, F.tid);
#if defined(PROBE_DUP_G)
            xcd_barrier(bar);
            pg8::gemm_phase<pg8::EpiGate, pg8::PairOrder, PG8_ALIGN, PG8_SP2>(F.lds + RING_OFF, g, S, E, F.tid);
#endif
            SEAM(g0 + 4);
        }
        if (IN(g0 + 5)) {
            relaunder(F); unsigned char* ws = F.ws; unsigned char* wl = ws + WS_WL + (size_t)l * WL_STRIDE; unsigned char* wd = ws + WS_WD + (size_t)fi * WD_STRIDE; unsigned char* wm = ws + WS_WM + (size_t)fi * WM_STRIDE; (void)wl; (void)wd; (void)wm;
            pg8::Gemm g{(const pbf*)(ws + WS_MERGED), (const pbf*)(wl + WL_WO), TC, DM, DM}; pg8::StaticOrder S; S.init(TC, DM, F.G, (int)blockIdx.x);
            pg8::EpiPlain E{(pbf*)(ws + WS_MIX), DM, 0x7fffffff, 0x7fffffff, 0u, 1.0f, 1.0f};
            pg8::gemm_phase<pg8::EpiPlain, pg8::StaticOrder, PG8_ALIGN, PG8_SP2>(F.lds + RING_OFF, g, S, E, F.tid);
#if defined(PROBE_DUP_G)
            xcd_barrier(bar);
            pg8::gemm_phase<pg8::EpiPlain, pg8::StaticOrder, PG8_ALIGN, PG8_SP2>(F.lds + RING_OFF, g, S, E, F.tid);
#endif
            SEAM(g0 + 5);
        }
        if (IN(g0 + 6)) { relaunder(F); if (moe) ln_phase<1, true>(F, chunk, GIN(14) + l * DM, GIN(15) + l * DM, GIN(21) + (size_t)fi * DM * NEXP, false, FP8_MOE_UP != 0); else ln_phase<2, false>(F, chunk, GIN(14) + l * DM, GIN(15) + l * DM, nullptr, false, FP8_DENSE_UP != 0); SEAM(g0 + 6); }
        if (!moe) {
            if (IN(g0 + 8)) {
            relaunder(F); unsigned char* ws = F.ws; unsigned char* wl = ws + WS_WL + (size_t)l * WL_STRIDE; unsigned char* wd = ws + WS_WD + (size_t)fi * WD_STRIDE; unsigned char* wm = ws + WS_WM + (size_t)fi * WM_STRIDE; (void)wl; (void)wd; (void)wm;
                pg8::StaticOrder S; S.init(TC, 2 * DFF, F.G, (int)blockIdx.x);
#if FP8_DENSE_UP
                pg8::Gemm g{(const pbf*)(ws + WS_XB8), (const pbf*)(wd + WD_W13), TC, 2 * DFF, DM / 2};
#if FP8_DENSE_DOWN
                pg8::EpiSwiGlu<true> E{(pbf*)(ws + WS_U8), DFF8, 0x7fffffff, nullptr, 1.0f / W8_SCALE, U8_SCALE};
                pg8::gemm_phase<pg8::EpiSwiGlu<true>, pg8::StaticOrder, PG8_ALIGN, PG8_SP2, true>(F.lds + RING_OFF, g, S, E, F.tid);
#else
                pg8::EpiSwiGlu<false> E{(pbf*)(ws + WS_U), DFF, 0x7fffffff, nullptr, 1.0f / W8_SCALE, 1.0f};
                pg8::gemm_phase<pg8::EpiSwiGlu<false>, pg8::StaticOrder, PG8_ALIGN, PG8_SP2, true>(F.lds + RING_OFF, g, S, E, F.tid);
#endif
#else
                pg8::Gemm g{(const pbf*)(ws + WS_XB), (const pbf*)(wd + WD_W13), TC, 2 * DFF, DM};
                pg8::EpiSwiGlu<false> E{(pbf*)(ws + WS_U), DFF, 0x7fffffff, nullptr, 1.0f, 1.0f};
                pg8::gemm_phase<pg8::EpiSwiGlu<false>, pg8::StaticOrder, PG8_ALIGN, PG8_SP2>(F.lds + RING_OFF, g, S, E, F.tid);
#endif
#if defined(PROBE_DUP_G)
            xcd_barrier(bar);
                pg8::gemm_phase<pg8::EpiSwiGlu, pg8::StaticOrder, PG8_ALIGN, PG8_SP2>(F.lds + RING_OFF, g, S, E, F.tid);
#endif
                SEAM(g0 + 8);
            }
            if (IN(g0 + 9)) {
            relaunder(F); unsigned char* ws = F.ws; unsigned char* wl = ws + WS_WL + (size_t)l * WL_STRIDE; unsigned char* wd = ws + WS_WD + (size_t)fi * WD_STRIDE; unsigned char* wm = ws + WS_WM + (size_t)fi * WM_STRIDE; (void)wl; (void)wd; (void)wm;
                pg8::StaticOrder S; S.init(TC, DM, F.G, (int)blockIdx.x);
#if FP8_DENSE_DOWN
                pg8::Gemm g{(const pbf*)(ws + WS_U8), (const pbf*)(wd + WD_W2), TC, DM, DFF8 / 2};
                pg8::EpiPlain E{(pbf*)(ws + WS_MIX), DM, 0x7fffffff, 0x7fffffff, 0u, 1.0f, 1.0f / (W8_SCALE * U8_SCALE)};
                pg8::gemm_phase<pg8::EpiPlain, pg8::StaticOrder, PG8_ALIGN, PG8_SP2, true>(F.lds + RING_OFF, g, S, E, F.tid);
#else
                pg8::Gemm g{(const pbf*)(ws + WS_U), (const pbf*)(wd + WD_W2), TC, DM, DFF};
                pg8::EpiPlain E{(pbf*)(ws + WS_MIX), DM, 0x7fffffff, 0x7fffffff, 0u, 1.0f, 1.0f};
                pg8::gemm_phase<pg8::EpiPlain, pg8::StaticOrder, PG8_ALIGN, PG8_SP2>(F.lds + RING_OFF, g, S, E, F.tid);
#endif
#if defined(PROBE_DUP_G)
            xcd_barrier(bar);
                pg8::gemm_phase<pg8::EpiPlain, pg8::StaticOrder, PG8_ALIGN, PG8_SP2>(F.lds + RING_OFF, g, S, E, F.tid);
#endif
                SEAM(g0 + 9);
            }
            if (IN(g0 + 10)) { relaunder(F); ln_phase<2, false>(F, chunk, GIN(16) + l * DM, GIN(17) + l * DM, nullptr, l + 1 == DEPTH, (FP8_INPROJ_QKV | FP8_INPROJ_GATES) != 0); SEAM(g0 + 10); }
        } else {
#ifndef ASSIGN_REPS
#define ASSIGN_REPS 1
#endif
            if (IN(g0 + 7)) { relaunder(F); for (int rep = 0; rep < ASSIGN_REPS; ++rep) moe_assign_phase(F);
#if defined(PROBE_DUP_K7)
                xcd_barrier(bar); moe_assign_phase(F);
#endif
                SEAM(g0 + 7); }
            if (IN(g0 + 8) || IN(g0 + 9)) {
                relaunder(F);
                const int* mo = (const int*)(F.ws + WS_MOEOFF);
                #define RFL(x) __builtin_amdgcn_readfirstlane(x)
                pg8::MoeOrder S; S.po1 = RFL(mo[1] >> 8); S.po2 = RFL(mo[2] >> 8); S.po3 = RFL(mo[3] >> 8); S.po4 = RFL(mo[4] >> 8); S.po5 = RFL(mo[5] >> 8); S.po6 = RFL(mo[6] >> 8); S.po7 = RFL(mo[7] >> 8); S.P = RFL(mo[8] >> 8);
#undef RFL
                S.G = F.G; S.c = F.vcu;
                if (S.P > SLOTS_MAX / 256) S.P = SLOTS_MAX / 256;
                if (IN(g0 + 8)) {
            relaunder(F); unsigned char* ws = F.ws; unsigned char* wl = ws + WS_WL + (size_t)l * WL_STRIDE; unsigned char* wd = ws + WS_WD + (size_t)fi * WD_STRIDE; unsigned char* wm = ws + WS_WM + (size_t)fi * WM_STRIDE; (void)wl; (void)wd; (void)wm;
#if FP8_MOE_UP
                    pg8::Gemm g{(const pbf*)(ws + WS_HBG), (const pbf*)(wm + WM_W13), SLOTS_MAX, NEXP * 2048, DM / 2};
                    constexpr float kInS = 1.0f / W8_SCALE; constexpr bool kUp8 = true;
#else
                    pg8::Gemm g{(const pbf*)(ws + WS_HBG), (const pbf*)(wm + WM_W13), SLOTS_MAX, NEXP * 2048, DM};
                    constexpr float kInS = 1.0f; constexpr bool kUp8 = false;
#endif
                    #if FP8_MOE_DOWN
                    pg8::EpiSwiGlu<true> E{(pbf*)(ws + WS_UM), DFE, 7, (const float*)(ws + WS_SLOTGATE), kInS, U8_SCALE};
                    pg8::gemm_phase<pg8::EpiSwiGlu<true>, pg8::MoeOrder, PG8_ALIGN, PG8_SP2, kUp8>(F.lds + RING_OFF, g, S, E, F.tid);
#else
                    pg8::EpiSwiGlu<false> E{(pbf*)(ws + WS_UM), DFE, 7, (const float*)(ws + WS_SLOTGATE), kInS, 1.0f};
                    pg8::gemm_phase<pg8::EpiSwiGlu<false>, pg8::MoeOrder, PG8_ALIGN, PG8_SP2, kUp8>(F.lds + RING_OFF, g, S, E, F.tid);
#endif
#if defined(PROBE_DUP_G)
            xcd_barrier(bar);
                    pg8::gemm_phase<pg8::EpiSwiGlu, pg8::MoeOrder, PG8_ALIGN, PG8_SP2>(F.lds + RING_OFF, g, S, E, F.tid);
#endif
                    SEAM(g0 + 8);
                }
                if (IN(g0 + 9)) {
            relaunder(F); unsigned char* ws = F.ws; unsigned char* wl = ws + WS_WL + (size_t)l * WL_STRIDE; unsigned char* wd = ws + WS_WD + (size_t)fi * WD_STRIDE; unsigned char* wm = ws + WS_WM + (size_t)fi * WM_STRIDE; (void)wl; (void)wd; (void)wm;
#if FP8_MOE_DOWN
                    pg8::Gemm g{(const pbf*)(ws + WS_UM), (const pbf*)(wm + WM_W2), SLOTS_MAX, NEXP * 2048, DFE / 2};
                    pg8::EpiPlain E{(pbf*)(ws + WS_OM), DM, 7, 0x7fffffff, 0u, 1.0f, 1.0f / (W8_SCALE * U8_SCALE)};
                    pg8::gemm_phase<pg8::EpiPlain, pg8::MoeOrder, PG8_ALIGN, PG8_SP2, true>(F.lds + RING_OFF, g, S, E, F.tid);
#else
                    pg8::Gemm g{(const pbf*)(ws + WS_UM), (const pbf*)(wm + WM_W2), SLOTS_MAX, NEXP * 2048, DFE};
                    pg8::EpiPlain E{(pbf*)(ws + WS_OM), DM, 7, 0x7fffffff, 0u, 1.0f, 1.0f};
                    pg8::gemm_phase<pg8::EpiPlain, pg8::MoeOrder, PG8_ALIGN, PG8_SP2>(F.lds + RING_OFF, g, S, E, F.tid);
#endif
#if defined(PROBE_DUP_G)
            xcd_barrier(bar);
                    pg8::gemm_phase<pg8::EpiPlain, pg8::MoeOrder, PG8_ALIGN, PG8_SP2>(F.lds + RING_OFF, g, S, E, F.tid);
#endif
                    SEAM(g0 + 9);
                }
            }
            if (IN(g0 + 10)) { relaunder(F); ln_phase<3, false>(F, chunk, GIN(16) + l * DM, GIN(17) + l * DM, nullptr, l + 1 == DEPTH, (FP8_INPROJ_QKV | FP8_INPROJ_GATES) != 0); SEAM(g0 + 10); }
        }
    }
#undef IN
#undef SEAM
}

extern "C" void kernel_launch(void* const* d_in, const int* in_sizes, int n_in, void* d_out, int out_size, void* d_ws, size_t ws_size, hipStream_t stream) {
    static int grid = 0;
    if (grid == 0) {
        if (n_in != 25 || in_sizes[0] != TPROMPT * DM || in_sizes[1] != (TTOT - TPROMPT) * DM || out_size != TTOT * DM || ws_size < WS_END) {
            fprintf(stderr, "kernel_launch: shape/workspace mismatch (n_in %d, ws %zu, need %zu); nothing launched\n", n_in, ws_size, (size_t)WS_END); grid = -1; return; }
        int dev = 0, cus = 0;
        if (hipGetDevice(&dev) != hipSuccess || hipDeviceGetAttribute(&cus, hipDeviceAttributeMultiprocessorCount, dev) != hipSuccess) { grid = -1; return; }
        if (hipFuncSetAttribute((const void*)mk_fwd, hipFuncAttributeMaxDynamicSharedMemorySize, LDS_BYTES) != hipSuccess) { fprintf(stderr, "kernel_launch: hipFuncSetAttribute failed\n"); grid = -1; return; }
        int per_cu = 0;
        if (hipOccupancyMaxActiveBlocksPerMultiprocessor(&per_cu, (const void*)mk_fwd, NWAVES * 64, LDS_BYTES) != hipSuccess || per_cu < 1)
            fprintf(stderr, "kernel_launch: note: occupancy query reports %d workgroups per CU\n", per_cu);
        (void)hipGetLastError();
        grid = cus;
    }
    if (grid < 0) return;
    if (hipMemsetAsync((char*)d_ws + WS_CTL, 0, CTL_ZERO_BYTES, stream) != hipSuccess) return;
    Args a{};
    for (int i = 0; i < 25; ++i) a.in[i] = (const float*)d_in[i];
    a.out = (float*)d_out; a.ws = (unsigned char*)d_ws;
#if MK_PER_PHASE
    for (int g = 0; g < NGID; ++g) {
        if (g > 0) { const int k = (g - 1) % NPH, l = ((g - 1) / NPH) % DEPTH; if (k == 0 && l != 0) continue; if (k == 3) continue; if (k == 7 && !(l & 1)) continue; }
        a.lo = g; a.hi = g + 1;
        hipLaunchKernelGGL(mk_fwd, dim3(grid), dim3(NWAVES * 64), LDS_BYTES, stream, a);
    }
#else
    a.lo = 0; a.hi = NGID;
    hipLaunchKernelGGL(mk_fwd, dim3(grid), dim3(NWAVES * 64), LDS_BYTES, stream, a);
#endif
    const hipError_t le = hipPeekAtLastError();
    if (le != hipSuccess) fprintf(stderr, "kernel_launch: launch failed: %s\n", hipGetErrorName(le));
}
```

```cpp
#include <hip/hip_runtime.h>
#include <hip/hip_bf16.h>
#include <cstdio>
#include <cstdint>
#include <cmath>

#ifndef MK_PER_PHASE
#define MK_PER_PHASE 0
#endif

namespace pg8 {
#define PG8_LAS __attribute__((address_space(3)))
typedef unsigned short bf16_t;
typedef short bf16x8 __attribute__((ext_vector_type(8)));
typedef float f32x4 __attribute__((ext_vector_type(4)));
typedef unsigned u32x4 __attribute__((ext_vector_type(4)));
constexpr int BM = 256, BK = 64, HALF = 128, HTB = HALF * BK * 2  , STAGE_BYTES = 8 * HTB, NXCD = 8, WGM = 8;

__host__ __device__ __forceinline__ int lds_byte(int r, int c) { const int st = (r >> 4) * 2 + (c >> 5), rr = r & 15, cc = c & 31, ob = rr * 64 + cc * 2; return st * 1024 + (ob ^ (((ob >> 9) & 1) << 5)); }
__host__ __device__ __forceinline__ void stage_rc(int b, int& R, int& C) { const int st = b / 1024, sb = b % 1024, swz = sb ^ (((sb >> 9) & 1) << 5); R = (st >> 1) * 16 + swz / 64; C = (st & 1) * 32 + (swz % 64) / 2; }
__host__ __device__ __forceinline__ int perm32(int rho) { const int n = rho >> 4, i = rho & 15; return 8 * (i >> 2) + 4 * n + (i & 3); }

struct Unit { int pm, pn; };
struct Gemm { const bf16_t* A; const bf16_t* Bt; int M, N, K; };

struct StaticOrder {
    int nM, nN, nwg, G, c;
    __host__ __device__ void init(int M, int N, int G_, int c_) { nM = M / BM; nN = N / BM; nwg = nM * nN; G = G_; c = c_; }
    __host__ __device__ bool next(int i, Unit& u) const {
        if (G >= nM && G % nM == 0) {
            const int cpr = G / nM, pn = i * cpr + c / nM;
            if (pn >= nN) return false; u.pm = c % nM; u.pn = pn; return true; }
        const long L = (long)i * G + c; if (L >= nwg) return false;
        int wgid = (int)L; { const int q = nwg / NXCD, r = nwg % NXCD, xcd = wgid % NXCD, off = wgid / NXCD; wgid = (xcd < r ? xcd * (q + 1) : r * (q + 1) + (xcd - r) * q) + off; }
        const int nig = WGM * nN, gid = wgid / nig, fm = gid * WGM, gsz = (nM - fm) < WGM ? (nM - fm) : WGM;
        u.pm = fm + ((wgid % nig) % gsz); u.pn = (wgid % nig) / gsz; return true;
    }
    __device__ __forceinline__ void a_ready(const Unit&) const {}
    __device__ __forceinline__ void done(const Unit&) const {}
};


__device__ __forceinline__ unsigned cvt_pk_bf16(float lo, float hi) { unsigned r; asm volatile("v_cvt_pk_bf16_f32 %0, %1, %2" : "=v"(r) : "v"(lo), "v"(hi)); return r; }
__device__ __forceinline__ float bf_lo(unsigned w) { return __uint_as_float(w << 16); }
__device__ __forceinline__ float bf_hi(unsigned w) { return __uint_as_float(w & 0xffff0000u); }
__device__ __forceinline__ float sigmoidf_fast(float x) { return __builtin_amdgcn_rcpf(1.0f + __builtin_amdgcn_exp2f(-1.4426950408889634f * x)); }
#ifndef EPI_WT
#define EPI_WT 0
#endif
__device__ __forceinline__ void st16(void* p, u32x4 v) {
#if EPI_WT
    asm volatile("global_store_dwordx4 %0, %1, off sc1" :: "v"(p), "v"(v) : "memory");
#else
    *(u32x4*)p = v;
#endif
}
__device__ __forceinline__ u32x4 pack8(f32x4 v0, f32x4 v1) { u32x4 w; w.x = cvt_pk_bf16(v0[0], v0[1]); w.y = cvt_pk_bf16(v0[2], v0[3]); w.z = cvt_pk_bf16(v1[0], v1[1]); w.w = cvt_pk_bf16(v1[2], v1[3]); return w; }

struct EpiPlain {
    static constexpr bool PERM = true, AFTER_DRAIN = false;
    bf16_t* O; int ldc; int pn_mask; int gate_pn0; unsigned qmask; float qscale; float mul;
    __device__ __forceinline__ void operator()(const f32x4 (&acc)[2][2][4][2], const Unit& u, int wr, int wc, int fr, int fq) const {
        const int row0 = u.pm * BM + wr * 64 + fr; const int col0 = (u.pn & pn_mask) * BM + wc * 32 + 8 * fq; const bool sg = u.pn >= gate_pn0;
        const float sc = ((u.pn < 32 && ((qmask >> u.pn) & 1u)) ? qscale : 1.0f) * mul;
#pragma unroll
        for (int ai = 0; ai < 2; ++ai)
#pragma unroll
            for (int m = 0; m < 4; ++m) { bf16_t* rowp = O + (size_t)(row0 + ai * HALF + m * 16) * ldc + col0;
#pragma unroll
                for (int bj = 0; bj < 2; ++bj) { f32x4 v0 = acc[ai][bj][m][0] * sc, v1 = acc[ai][bj][m][1] * sc;
                    if (sg) {
#pragma unroll
                        for (int k = 0; k < 4; ++k) { v0[k] = sigmoidf_fast(v0[k]); v1[k] = sigmoidf_fast(v1[k]); } }
                    st16(rowp + bj * HALF, pack8(v0, v1)); } }
    }
};
struct EpiGate {
    static constexpr bool PERM = true, AFTER_DRAIN = false;
    const bf16_t* G; int ldg; bf16_t* O; int ldc; int nM;
    __device__ __forceinline__ void operator()(f32x4 (&acc)[2][2][4][2], const Unit& u, int wr, int wc, int fr, int fq) const {
        const int part = u.pn >= 8 ? 1 : 0; const int pm = u.pm - part * nM, pn = u.pn - part * 8;
        const int row0 = pm * BM + wr * 64 + fr; const int col0 = pn * BM + wc * 32 + 8 * fq;
        u32x4 g[2][4][2];
#pragma unroll
        for (int ai = 0; ai < 2; ++ai)
#pragma unroll
            for (int m = 0; m < 4; ++m)
#pragma unroll
                for (int bj = 0; bj < 2; ++bj) g[ai][m][bj] = *(const u32x4*)(G + (size_t)(row0 + ai * HALF + m * 16) * ldg + part * 2048 + col0 + bj * HALF);
        __builtin_amdgcn_sched_barrier(0);
#pragma unroll
        for (int ai = 0; ai < 2; ++ai)
#pragma unroll
            for (int m = 0; m < 4; ++m)
#pragma unroll
                for (int bj = 0; bj < 2; ++bj) { const u32x4 w = g[ai][m][bj]; f32x4& v0 = acc[ai][bj][m][0]; f32x4& v1 = acc[ai][bj][m][1];
                    v0[0] *= bf_lo(w.x); v0[1] *= bf_hi(w.x); v0[2] *= bf_lo(w.y); v0[3] *= bf_hi(w.y);
                    v1[0] *= bf_lo(w.z); v1[1] *= bf_hi(w.z); v1[2] *= bf_lo(w.w); v1[3] *= bf_hi(w.w); }
        if (part) {
#pragma unroll
            for (int ai = 0; ai < 2; ++ai)
#pragma unroll
                for (int m = 0; m < 4; ++m)
#pragma unroll
                    for (int bj = 0; bj < 2; ++bj) g[ai][m][bj] = *(const u32x4*)(O + (size_t)(row0 + ai * HALF + m * 16) * ldc + col0 + bj * HALF);
            __builtin_amdgcn_sched_barrier(0);
#pragma unroll
            for (int ai = 0; ai < 2; ++ai)
#pragma unroll
                for (int m = 0; m < 4; ++m)
#pragma unroll
                    for (int bj = 0; bj < 2; ++bj) { const u32x4 w = g[ai][m][bj]; f32x4& v0 = acc[ai][bj][m][0]; f32x4& v1 = acc[ai][bj][m][1];
                        v0[0] += bf_lo(w.x); v0[1] += bf_hi(w.x); v0[2] += bf_lo(w.y); v0[3] += bf_hi(w.y);
                        v1[0] += bf_lo(w.z); v1[1] += bf_hi(w.z); v1[2] += bf_lo(w.w); v1[3] += bf_hi(w.w); }
        }
#pragma unroll
        for (int ai = 0; ai < 2; ++ai)
#pragma unroll
            for (int m = 0; m < 4; ++m)
#pragma unroll
                for (int bj = 0; bj < 2; ++bj) *(u32x4*)(O + (size_t)(row0 + ai * HALF + m * 16) * ldc + col0 + bj * HALF) = pack8(acc[ai][bj][m][0], acc[ai][bj][m][1]);
    }
};
template <bool OUT8>
struct EpiSwiGlu {
    static constexpr bool PERM = true, AFTER_DRAIN = false;
    bf16_t* O; int ldc; int pn_mask; const float* rowgate; float in_scale; float out_scale;
    __device__ __forceinline__ void operator()(const f32x4 (&acc)[2][2][4][2], const Unit& u, int wr, int wc, int fr, int fq) const {
        const int row0 = u.pm * BM + wr * 64 + fr; const int col0 = (u.pn & pn_mask) * HALF + wc * 32 + 8 * fq;
#pragma unroll
        for (int ai = 0; ai < 2; ++ai)
#pragma unroll
            for (int m = 0; m < 4; ++m) { const size_t row = (size_t)(row0 + ai * HALF + m * 16);
                const float rg = (rowgate ? rowgate[row] : 1.0f) * out_scale;
                f32x4 v0, v1;
#pragma unroll
                for (int k = 0; k < 4; ++k) { const float a0 = acc[ai][0][m][0][k] * in_scale, a1 = acc[ai][0][m][1][k] * in_scale;
                    v0[k] = a0 * sigmoidf_fast(a0) * (acc[ai][1][m][0][k] * in_scale) * rg; v1[k] = a1 * sigmoidf_fast(a1) * (acc[ai][1][m][1][k] * in_scale) * rg; }
                if (OUT8) { unsigned lo = 0, hi = 0;
                    lo = __builtin_amdgcn_cvt_pk_fp8_f32(v0[0], v0[1], lo, false); lo = __builtin_amdgcn_cvt_pk_fp8_f32(v0[2], v0[3], lo, true);
                    hi = __builtin_amdgcn_cvt_pk_fp8_f32(v1[0], v1[1], hi, false); hi = __builtin_amdgcn_cvt_pk_fp8_f32(v1[2], v1[3], hi, true);
                    typedef unsigned u32x2_ __attribute__((ext_vector_type(2)));
                    *(u32x2_*)((unsigned char*)O + row * ldc + col0) = (u32x2_){lo, hi}; }
                else st16(O + row * ldc + col0, pack8(v0, v1)); }
    }
};
struct PairOrder {
    StaticOrder so;
    __device__ void init(int M, int G_, int c_) { so.init(M, 2048, G_, c_); }
    __device__ bool next(int i, Unit& u) const { Unit t; if (!so.next(i >> 1, t)) return false; const int part = i & 1; u.pm = t.pm + part * so.nM; u.pn = t.pn + part * so.nN; return true; }
    __device__ __forceinline__ void a_ready(const Unit&) const {}
    __device__ __forceinline__ void done(const Unit&) const {}
};
struct UnevenOrder {
    StaticOrder so; int n_mine, first, Gs, tpm, tpn;
    __device__ void init(int M, int N, int G_, int c_, int nfirst, int n_lo, int n_hi) {
        so.init(M, N, 1, 0); Gs = G_; tpm = -1; tpn = 0; const int heavy = nfirst % G_;
        if (heavy * n_lo + (G_ - heavy) * n_hi == so.nwg) { if (c_ < heavy) { n_mine = n_lo; first = (G_ - heavy) * n_hi + c_ * n_lo; } else { n_mine = n_hi; first = (c_ - heavy) * n_hi; }
            if (G_ == 4 * so.nM && heavy == 2 * so.nM && 2 * n_lo + 2 * n_hi == so.nN) {
                const int k = c_ / so.nM; tpm = c_ % so.nM; tpn = k < 2 ? k * n_lo : 2 * n_lo + (k - 2) * n_hi; } }
        else { n_mine = (so.nwg - c_ + G_ - 1) / G_; first = -1 - c_; }
    }
    __device__ bool next(int i, Unit& u) const { if (i >= n_mine) return false; if (tpm >= 0) { u.pm = tpm; u.pn = tpn + i; return true; } return first >= 0 ? so.next(first + i, u) : so.next(i * Gs + (-1 - first), u); }
    __device__ __forceinline__ void a_ready(const Unit&) const {}
    __device__ __forceinline__ void done(const Unit&) const {}
};
struct MoeOrder {
    int po1, po2, po3, po4, po5, po6, po7, P, G, c;
    __device__ bool next(int i, Unit& u) const {
        const int L = i * G + c; if (L >= P * 8) return false;
        const int p = L >> 3, t = L & 7;
        const int e = (p >= po1) + (p >= po2) + (p >= po3) + (p >= po4) + (p >= po5) + (p >= po6) + (p >= po7);
        u.pm = p; u.pn = e * 8 + t; return true;
    }
    __device__ __forceinline__ void a_ready(const Unit&) const {}
    __device__ __forceinline__ void done(const Unit&) const {}
};

typedef int i32x4_ __attribute__((ext_vector_type(4))); typedef int i32x8_ __attribute__((ext_vector_type(8)));
template <class Epi, class Sched, bool ALIGN_EPI = false, bool SP2 = false, bool FP8 = false>
__device__ __forceinline__ void gemm_phase(PG8_LAS unsigned char* lds, const Gemm g, const Sched& S, const Epi& E, int tid_in) {
    int tid_ = tid_in; asm volatile("" : "+v"(tid_));
    const int tid = tid_, wid = __builtin_amdgcn_readfirstlane(tid >> 6), lane = tid & 63, wr = wid >> 2, wc = wid & 3, fr = lane & 15, fq = lane >> 4;
    const int K = g.K, nt = K / BK;
    unsigned voffA[2], voffB[2];
#pragma unroll
    for (int i = 0; i < 2; ++i) { int R, C; stage_rc(tid * 16 + i * 8192, R, C); const int Rb = Epi::PERM ? ((R & ~31) + perm32(R & 31)) : R;
        voffA[i] = (unsigned)(R * K + C) * 2u; voffB[i] = (unsigned)(Rb * K + C) * 2u; }
    const size_t kstep = (size_t)(BK * 2);
    const size_t hstep = (size_t)HALF * K * 2;
    const size_t tstep = 2 * hstep;
    const unsigned ldsw = (unsigned)wid * 1024u;
    const int aoff = lds_byte(wr * 64 + fr, fq * 8), boff = lds_byte(wc * 32 + fr, fq * 8);
#define PG8_SA(b, h) (((b) * 2 + (h)) * HTB)
#define PG8_SB(b, h) ((4 + (b) * 2 + (h)) * HTB)
#define PG8_STAGE(bufoff, gbase, voff) do { _Pragma("unroll") for (int _i = 0; _i < 2; ++_i) \
        __builtin_amdgcn_global_load_lds((const unsigned*)((const char*)(gbase) + (voff)[_i]), (PG8_LAS unsigned*)(lds + (bufoff) + ldsw + _i * 8192), 16, 0, 0); } while (0)
#define PG8_LDA(dst, b, h) do { _Pragma("unroll") for (int m = 0; m < 4; ++m) _Pragma("unroll") for (int k = 0; k < 2; ++k) dst[m][k] = *(const PG8_LAS bf16x8*)(lds + PG8_SA(b, h) + aoff + m * 2048 + k * 1024); } while (0)
#define PG8_LDB(dst, b, h) do { _Pragma("unroll") for (int n = 0; n < 2; ++n) _Pragma("unroll") for (int k = 0; k < 2; ++k) dst[n][k] = *(const PG8_LAS bf16x8*)(lds + PG8_SB(b, h) + boff + n * 2048 + k * 1024); } while (0)
#define PG8_MMA(ai, bj, At, Bt) do { __builtin_amdgcn_s_setprio(1); if constexpr (FP8) { _Pragma("unroll") for (int m = 0; m < 4; ++m) _Pragma("unroll") for (int n = 0; n < 2; ++n) { \
        const i32x8_ b8_ = __builtin_shufflevector(__builtin_bit_cast(i32x4_, Bt[n][0]), __builtin_bit_cast(i32x4_, Bt[n][1]), 0, 1, 2, 3, 4, 5, 6, 7); \
        const i32x8_ a8_ = __builtin_shufflevector(__builtin_bit_cast(i32x4_, At[m][0]), __builtin_bit_cast(i32x4_, At[m][1]), 0, 1, 2, 3, 4, 5, 6, 7); \
        asm volatile("v_mfma_scale_f32_16x16x128_f8f6f4 %0, %1, %2, %0, %3, %3 op_sel_hi:[0,0,0]" : "+v"(acc[ai][bj][m][n]) : "v"(b8_), "v"(a8_), "v"(sc8_)); } } \
      else { _Pragma("unroll") for (int m = 0; m < 4; ++m) _Pragma("unroll") for (int n = 0; n < 2; ++n) _Pragma("unroll") for (int k = 0; k < 2; ++k) \
        acc[ai][bj][m][n] = __builtin_amdgcn_mfma_f32_16x16x32_bf16(Bt[n][k], At[m][k], acc[ai][bj][m][n], 0, 0, 0); } __builtin_amdgcn_s_setprio(0); } while (0)
#define PG8_WAIT_V(n) asm volatile("s_waitcnt vmcnt(" #n ")" ::: "memory")
#define PG8_WAIT_L(n) asm volatile("s_waitcnt lgkmcnt(" #n ")" ::: "memory")
#define PG8_BAR __builtin_amdgcn_s_barrier()
#define PG8_SCHED __builtin_amdgcn_sched_barrier(0)
    Unit cur, nxt; int ui = 0;
    if (!S.next(0, cur)) return;
    f32x4 acc[2][2][4][2];
#pragma unroll
    for (int a = 0; a < 2; ++a)
#pragma unroll
        for (int b = 0; b < 2; ++b)
#pragma unroll
            for (int m = 0; m < 4; ++m)
#pragma unroll
                for (int n = 0; n < 2; ++n) acc[a][b][m][n] = (f32x4){0.f, 0.f, 0.f, 0.f};
    bf16x8 At[4][2], B0[2][2], B1[2][2];
    int sc8_ = 0x7F7F7F7F; asm volatile("" : "+v"(sc8_));
    const char* cA = (const char*)g.A + (size_t)cur.pm * tstep; const char* cB = (const char*)g.Bt + (size_t)cur.pn * tstep;
    S.a_ready(cur);
    if constexpr (SP2) {
        PG8_STAGE(PG8_SB(0, 0), cB, voffB); PG8_STAGE(PG8_SB(0, 1), cB + hstep, voffB); PG8_STAGE(PG8_SA(0, 0), cA, voffA); PG8_STAGE(PG8_SA(0, 1), cA + hstep, voffA);
        if (wr == 1) PG8_BAR;
        PG8_WAIT_V(2); PG8_BAR;
        PG8_STAGE(PG8_SB(1, 0), cB + kstep, voffB); PG8_STAGE(PG8_SA(1, 0), cA + kstep, voffA); PG8_STAGE(PG8_SB(1, 1), cB + hstep + kstep, voffB);
        PG8_WAIT_V(6); PG8_BAR;
    } else {
        PG8_STAGE(PG8_SB(0, 0), cB, voffB); PG8_STAGE(PG8_SA(0, 0), cA, voffA); PG8_STAGE(PG8_SB(0, 1), cB + hstep, voffB); PG8_STAGE(PG8_SA(0, 1), cA + hstep, voffA);
        if (wr == 1) PG8_BAR;
        PG8_WAIT_V(4); PG8_BAR;
        PG8_STAGE(PG8_SB(1, 0), cB + kstep, voffB); PG8_STAGE(PG8_SA(1, 0), cA + kstep, voffA); PG8_STAGE(PG8_SB(1, 1), cB + hstep + kstep, voffB);
        PG8_WAIT_V(6); PG8_BAR;
    }
    for (;;) {
        const bool has_next = S.next(ui + 1, nxt);
        const char* nA = has_next ? (const char*)g.A + (size_t)nxt.pm * tstep : cA; const char* nB = has_next ? (const char*)g.Bt + (size_t)nxt.pn * tstep : cB;
        for (int t = 0; t < nt; t += 2) {
            const bool last = (t == nt - 2);
            const char* a1 = cA + (size_t)(t + 1) * kstep;
            const char* a2 = last ? nA : cA + (size_t)(t + 2) * kstep; const char* b2 = last ? nB : cB + (size_t)(t + 2) * kstep;
            const char* a3 = a2 + kstep; const char* b3 = b2 + kstep;
            if (last && has_next) S.a_ready(nxt);
            if constexpr (SP2) {
            PG8_LDB(B0, 0, 0); PG8_LDB(B1, 0, 1); PG8_SCHED; PG8_LDA(At, 0, 0); PG8_STAGE(PG8_SA(1, 1), a1 + hstep, voffA);
            PG8_WAIT_V(8); PG8_WAIT_L(0); PG8_BAR; PG8_MMA(0, 0, At, B0); PG8_MMA(0, 1, At, B1); PG8_BAR; PG8_SCHED;
            PG8_LDA(At, 0, 1); PG8_STAGE(PG8_SB(0, 0), b2, voffB); PG8_STAGE(PG8_SB(0, 1), b2 + hstep, voffB); PG8_STAGE(PG8_SA(0, 0), a2, voffA);
            PG8_WAIT_V(8); PG8_WAIT_L(0); PG8_BAR; PG8_MMA(1, 0, At, B0); PG8_MMA(1, 1, At, B1); PG8_BAR; PG8_SCHED;
            PG8_LDB(B0, 1, 0); PG8_LDB(B1, 1, 1); PG8_SCHED; PG8_LDA(At, 1, 0); PG8_STAGE(PG8_SA(0, 1), a2 + hstep, voffA);
            PG8_WAIT_V(8); PG8_WAIT_L(0); PG8_BAR; PG8_MMA(0, 0, At, B0); PG8_MMA(0, 1, At, B1); PG8_BAR; PG8_SCHED;
            PG8_LDA(At, 1, 1); PG8_STAGE(PG8_SB(1, 0), b3, voffB); PG8_STAGE(PG8_SB(1, 1), b3 + hstep, voffB); PG8_STAGE(PG8_SA(1, 0), a3, voffA);
            PG8_WAIT_V(8); PG8_WAIT_L(0); PG8_BAR; PG8_MMA(1, 0, At, B0); PG8_MMA(1, 1, At, B1); PG8_BAR; PG8_SCHED;
            } else {
            PG8_LDB(B0, 0, 0); PG8_SCHED; PG8_LDA(At, 0, 0); PG8_STAGE(PG8_SA(1, 1), a1 + hstep, voffA);
            PG8_WAIT_L(8); PG8_BAR; PG8_WAIT_L(0); PG8_MMA(0, 0, At, B0); PG8_BAR; PG8_SCHED;
            PG8_LDB(B1, 0, 1); PG8_STAGE(PG8_SB(0, 0), b2, voffB);
            PG8_BAR; PG8_WAIT_L(0); PG8_MMA(0, 1, At, B1); PG8_BAR;
            PG8_LDA(At, 0, 1); PG8_STAGE(PG8_SA(0, 0), a2, voffA);
            PG8_BAR; PG8_WAIT_L(0); PG8_MMA(1, 0, At, B0); PG8_BAR; PG8_SCHED;
            PG8_STAGE(PG8_SB(0, 1), b2 + hstep, voffB);
            PG8_WAIT_V(6); PG8_BAR; PG8_MMA(1, 1, At, B1); PG8_BAR;
            PG8_LDB(B0, 1, 0); PG8_SCHED; PG8_LDA(At, 1, 0); PG8_STAGE(PG8_SA(0, 1), a2 + hstep, voffA);
            PG8_WAIT_L(8); PG8_BAR; PG8_WAIT_L(0); PG8_MMA(0, 0, At, B0); PG8_BAR; PG8_SCHED;
            PG8_LDB(B1, 1, 1); PG8_STAGE(PG8_SB(1, 0), b3, voffB);
            PG8_BAR; PG8_WAIT_L(0); PG8_MMA(0, 1, At, B1); PG8_BAR;
            PG8_LDA(At, 1, 1); PG8_STAGE(PG8_SA(1, 0), a3, voffA);
            PG8_BAR; PG8_WAIT_L(0); PG8_MMA(1, 0, At, B0); PG8_BAR; PG8_SCHED;
            PG8_STAGE(PG8_SB(1, 1), b3 + hstep, voffB);
            PG8_WAIT_V(6); PG8_BAR; PG8_MMA(1, 1, At, B1); PG8_BAR;
            }
        }
        if constexpr (ALIGN_EPI) { if (wr == 0) PG8_BAR; }
        if constexpr (FP8) asm volatile("s_nop 15\n\ts_nop 15" ::: "memory");
        if constexpr (!Epi::AFTER_DRAIN) { E(acc, cur, wr, wc, fr, fq); S.done(cur); }
        if (!has_next) break;
#pragma unroll
        for (int a = 0; a < 2; ++a)
#pragma unroll
            for (int b = 0; b < 2; ++b)
#pragma unroll
                for (int m = 0; m < 4; ++m)
#pragma unroll
                    for (int n = 0; n < 2; ++n) acc[a][b][m][n] = (f32x4){0.f, 0.f, 0.f, 0.f};
        cur = nxt; cA = nA; cB = nB; ++ui;
        if constexpr (ALIGN_EPI) { if (wr == 1) PG8_BAR; }
    }
    PG8_WAIT_V(0);
    if constexpr (!ALIGN_EPI) { if (wr == 0) PG8_BAR; }
    PG8_BAR;
    if constexpr (Epi::AFTER_DRAIN) { E.fused(acc, cur, wr, wc, fr, fq, lds, wid, lane); S.done(cur); }
#undef PG8_SA
#undef PG8_SB
#undef PG8_STAGE
#undef PG8_LDA
#undef PG8_LDB
#undef PG8_MMA
#undef PG8_WAIT_V
#undef PG8_WAIT_L
#undef PG8_BAR
#undef PG8_SCHED
}
}

#define PG8_SP2 true
#define PG8_ALIGN true

namespace att {
using bf16 = __hip_bfloat16;
constexpr int   D = 128, NW = 8, QBLK = 32, KVBLK = 64;
constexpr float SCALE = 0.088388347648318440f, LOG2E = 1.4426950408889634f, CS = SCALE * LOG2E;
constexpr float THR2 = 8.f * LOG2E;
constexpr int LDQ = 8704, LDK = 8704;
constexpr size_t SHM_V = KVBLK * D * 2, SHM_K = KVBLK * D * 2, SHM_ATTN = 2 * SHM_V + 2 * SHM_K + NW * 64 * 4;
using bf16x8 = __attribute__((ext_vector_type(8))) short;
using s16x4  = __attribute__((ext_vector_type(4))) short;
using f32x16 = __attribute__((ext_vector_type(16))) float;
using u32x4  = __attribute__((ext_vector_type(4))) unsigned;
using f32x4  = __attribute__((ext_vector_type(4))) float;
#define KSWZ(row, colB) ((row) * 256 + ((colB) ^ (((row) & 7) << 4)))
#define SBAR() __builtin_amdgcn_sched_barrier(0)
__device__ __forceinline__ int crow(int r, int hi) { return (r & 3) + 8 * (r >> 2) + 4 * hi; }
__device__ __forceinline__ unsigned cvtpk(float lo, float hi) {
  unsigned r; asm volatile("v_cvt_pk_bf16_f32 %0, %1, %2" : "=v"(r) : "v"(lo), "v"(hi)); return r;
}
#ifndef ATT_PV_PRIO
#define ATT_PV_PRIO 1
#endif
#ifndef ATT_BIAS_INIT
#define ATT_BIAS_INIT 0
#endif
#ifndef ATT_SDEPTH
#define ATT_SDEPTH 1
#endif
template <bool WIN>
__device__ __forceinline__ void partialSM(f32x16& p0, f32x16& p1, float& m_reg, float& mn, float& alpha, float dqh, float nsl) {
#if !ATT_BIAS_INIT
#pragma unroll
  for (int r = 0; r < 16; ++r) { const float d = fabsf(dqh - (float)((r & 3) + 8 * (r >> 2))); float t = fmaf(d, nsl, p0[r]); if (WIN) t = d <= 128.f ? t : -1e30f; p0[r] = t; }
#pragma unroll
  for (int r = 0; r < 16; ++r) { const float d = fabsf(dqh - (float)(32 + (r & 3) + 8 * (r >> 2))); float t = fmaf(d, nsl, p1[r]); if (WIN) t = d <= 128.f ? t : -1e30f; p1[r] = t; }
#endif
  float pmax = p0[0];
#pragma unroll
  for (int r = 1; r < 16; ++r) pmax = fmaxf(pmax, p0[r]);
#pragma unroll
  for (int r = 0; r < 16; ++r) pmax = fmaxf(pmax, p1[r]);
  { auto rr = __builtin_amdgcn_permlane32_swap(__float_as_uint(pmax), __float_as_uint(pmax), false, false);
    pmax = fmaxf(__uint_as_float(rr[0]), __uint_as_float(rr[1])); }
  if (__builtin_expect(__all(pmax - m_reg <= THR2), 1)) { mn = m_reg; alpha = 1.f; }
  else { mn = fmaxf(m_reg, pmax); alpha = __builtin_amdgcn_exp2f(m_reg - mn); m_reg = mn; }
#pragma unroll
  for (int r = 0; r < 16; ++r) p0[r] -= mn;
#pragma unroll
  for (int r = 0; r < 16; ++r) p1[r] -= mn;
#pragma unroll
  for (int r = 0; r < 16; ++r) p0[r] = __builtin_amdgcn_exp2f(p0[r]);
}
__device__ __forceinline__ void finishSM(f32x16& p0, f32x16& p1, float alpha, float& l_reg, bf16x8& pa0, bf16x8& pa1, bf16x8& pa2, bf16x8& pa3) {
#pragma unroll
  for (int r = 0; r < 16; ++r) p1[r] = __builtin_amdgcn_exp2f(p1[r]);
  float ps = 0;
#pragma unroll
  for (int r = 0; r < 16; ++r) ps += p0[r];
#pragma unroll
  for (int r = 0; r < 16; ++r) ps += p1[r];
  { auto rr = __builtin_amdgcn_permlane32_swap(__float_as_uint(ps), __float_as_uint(ps), false, false);
    ps = __uint_as_float(rr[0]) + __uint_as_float(rr[1]); }
  l_reg = l_reg * alpha + ps;
#define PK4(P, BASE, OUT) do { unsigned a0 = cvtpk(P[BASE + 0], P[BASE + 1]), a1 = cvtpk(P[BASE + 2], P[BASE + 3]);   \
    unsigned b0 = cvtpk(P[BASE + 4], P[BASE + 5]), b1 = cvtpk(P[BASE + 6], P[BASE + 7]);                              \
    auto r0 = __builtin_amdgcn_permlane32_swap(a0, b0, false, false); auto r1 = __builtin_amdgcn_permlane32_swap(a1, b1, false, false); \
    u32x4 w = {r0[0], r1[0], r0[1], r1[1]}; OUT = *reinterpret_cast<bf16x8*>(&w); } while (0)
  PK4(p0, 0, pa0); PK4(p0, 8, pa1); PK4(p1, 0, pa2); PK4(p1, 8, pa3);
#undef PK4
}
template <bool WIN>
__device__ __forceinline__ void qkt(f32x16& p0, f32x16& p1, const bf16* Ks, const bf16x8* qr, int r32, int hi, float dqh, float nsl) {
#if ATT_BIAS_INIT
#pragma unroll
  for (int r = 0; r < 16; ++r) { const float d = fabsf(dqh - (float)((r & 3) + 8 * (r >> 2))); float b = nsl * d; if (WIN) b = d <= 128.f ? b : -1e30f; p0[r] = b; }
#pragma unroll
  for (int r = 0; r < 16; ++r) { const float d = fabsf(dqh - (float)(32 + (r & 3) + 8 * (r >> 2))); float b = nsl * d; if (WIN) b = d <= 128.f ? b : -1e30f; p1[r] = b; }
#else
  p0 = f32x16{}; p1 = f32x16{};
#endif
#pragma unroll
  for (int d0 = 0; d0 < 8; ++d0) { int cb = (d0 * 16 + hi * 8) * 2;
    bf16x8 b0 = *reinterpret_cast<const bf16x8*>((const char*)Ks + KSWZ(r32, cb));
    bf16x8 b1 = *reinterpret_cast<const bf16x8*>((const char*)Ks + KSWZ(32 + r32, cb));
    p0 = __builtin_amdgcn_mfma_f32_32x32x16_bf16(b0, qr[d0], p0, 0, 0, 0);
    p1 = __builtin_amdgcn_mfma_f32_32x32x16_bf16(b1, qr[d0], p1, 0, 0, 0); }
}
__device__ __forceinline__ int v_st(int k, int c) { const int kk = (k & ~0xC) | ((k & 4) << 1) | ((k & 8) >> 1); return ((kk >> 3) * 4 + (c >> 5)) * 512 + ((kk & 7) * 32 + (c & 31)) * 2; }
__device__ __forceinline__ int v_rd_base(int lane) { return ((lane & 3) << 3) | (((lane >> 2) & 3) << 6) | (((lane >> 4) & 1) << 5) | (((lane >> 5) & 1) << 8); }
constexpr int v_rd_off(int d0, int ks, int half) { return d0 * 512 + ks * 4096 + half * 2048; }
template <int OFF> __device__ __forceinline__ s16x4 tr_read(int vb) {
  s16x4 r; asm volatile("ds_read_b64_tr_b16 %0, %1 offset:%2" : "=&v"(r) : "v"(vb), "i"(OFF) : "memory"); return r;
}
template <int D0> __device__ __forceinline__ void pv_one(f32x16& od, int vb, bf16x8 pa0, bf16x8 pa1, bf16x8 pa2, bf16x8 pa3) {
  const s16x4 l0 = tr_read<v_rd_off(D0, 0, 0)>(vb), h0 = tr_read<v_rd_off(D0, 0, 1)>(vb), l1 = tr_read<v_rd_off(D0, 1, 0)>(vb), h1 = tr_read<v_rd_off(D0, 1, 1)>(vb);
  const s16x4 l2 = tr_read<v_rd_off(D0, 2, 0)>(vb), h2 = tr_read<v_rd_off(D0, 2, 1)>(vb), l3 = tr_read<v_rd_off(D0, 3, 0)>(vb), h3 = tr_read<v_rd_off(D0, 3, 1)>(vb);
  asm volatile("s_waitcnt lgkmcnt(0)" ::: "memory"); SBAR();
#define PK(L, H) (bf16x8){L[0], L[1], L[2], L[3], H[0], H[1], H[2], H[3]}
  od = __builtin_amdgcn_mfma_f32_32x32x16_bf16(pa0, PK(l0, h0), od, 0, 0, 0);
  od = __builtin_amdgcn_mfma_f32_32x32x16_bf16(pa1, PK(l1, h1), od, 0, 0, 0);
  od = __builtin_amdgcn_mfma_f32_32x32x16_bf16(pa2, PK(l2, h2), od, 0, 0, 0);
  od = __builtin_amdgcn_mfma_f32_32x32x16_bf16(pa3, PK(l3, h3), od, 0, 0, 0);
#undef PK
}
__device__ __forceinline__ void pv_d0(f32x16* o, int vb, bf16x8 pa0, bf16x8 pa1, bf16x8 pa2, bf16x8 pa3) {
  pv_one<0>(o[0], vb, pa0, pa1, pa2, pa3); pv_one<1>(o[1], vb, pa0, pa1, pa2, pa3); pv_one<2>(o[2], vb, pa0, pa1, pa2, pa3); pv_one<3>(o[3], vb, pa0, pa1, pa2, pa3);
}
template <int D0> __device__ __forceinline__ void pvT_one(f32x16& od, int vb, bf16x8 pa0, bf16x8 pa1, bf16x8 pa2, bf16x8 pa3) {
  const s16x4 l0 = tr_read<v_rd_off(D0, 0, 0)>(vb), h0 = tr_read<v_rd_off(D0, 0, 1)>(vb), l1 = tr_read<v_rd_off(D0, 1, 0)>(vb), h1 = tr_read<v_rd_off(D0, 1, 1)>(vb);
  const s16x4 l2 = tr_read<v_rd_off(D0, 2, 0)>(vb), h2 = tr_read<v_rd_off(D0, 2, 1)>(vb), l3 = tr_read<v_rd_off(D0, 3, 0)>(vb), h3 = tr_read<v_rd_off(D0, 3, 1)>(vb);
  asm volatile("s_waitcnt lgkmcnt(0)" ::: "memory"); SBAR();
#define PK(L, H) (bf16x8){L[0], L[1], L[2], L[3], H[0], H[1], H[2], H[3]}
  od = __builtin_amdgcn_mfma_f32_32x32x16_bf16(PK(l0, h0), pa0, od, 0, 0, 0);
  od = __builtin_amdgcn_mfma_f32_32x32x16_bf16(PK(l1, h1), pa1, od, 0, 0, 0);
  od = __builtin_amdgcn_mfma_f32_32x32x16_bf16(PK(l2, h2), pa2, od, 0, 0, 0);
  od = __builtin_amdgcn_mfma_f32_32x32x16_bf16(PK(l3, h3), pa3, od, 0, 0, 0);
#undef PK
}
template <int I> struct IC { static constexpr int v = I; };
struct NoHook { template <class T> __device__ __forceinline__ void operator()(T) const {} };
template <int I> __device__ __forceinline__ void pvT_half_rd(int vb, s16x4 (&f)[4]) {
  constexpr int BLK = I >> 1, HF = I & 1, D0 = BLK & 3, IMG = BLK >> 2;
  constexpr int O0 = IMG * (int)SHM_V + v_rd_off(D0, 2 * HF, 0), O1 = IMG * (int)SHM_V + v_rd_off(D0, 2 * HF, 1), O2 = IMG * (int)SHM_V + v_rd_off(D0, 2 * HF + 1, 0), O3 = IMG * (int)SHM_V + v_rd_off(D0, 2 * HF + 1, 1);
  f[0] = tr_read<O0>(vb); f[1] = tr_read<O1>(vb); f[2] = tr_read<O2>(vb); f[3] = tr_read<O3>(vb);
}
template <int I, int NH, class HK> __device__ __forceinline__ void pvT_step(f32x16* o, int vb, s16x4 (&cur)[4], s16x4 (&nxt)[4], bf16x8 pa0, bf16x8 pa1, bf16x8 pa2, bf16x8 pa3, const HK& hk) {
  hk(IC<I>{});
  if constexpr (I + 1 < NH) { pvT_half_rd<I + 1>(vb, nxt); asm volatile("s_waitcnt lgkmcnt(4)" ::: "memory"); }
  else asm volatile("s_waitcnt lgkmcnt(0)" ::: "memory");
  SBAR();
#define PK(L, H) (bf16x8){L[0], L[1], L[2], L[3], H[0], H[1], H[2], H[3]}
  constexpr int BLK = I >> 1, HF = I & 1;
  o[BLK] = __builtin_amdgcn_mfma_f32_32x32x16_bf16(PK(cur[0], cur[1]), HF ? pa2 : pa0, o[BLK], 0, 0, 0);
  o[BLK] = __builtin_amdgcn_mfma_f32_32x32x16_bf16(PK(cur[2], cur[3]), HF ? pa3 : pa1, o[BLK], 0, 0, 0);
#undef PK
  SBAR();
}
template <int NB, class HK = NoHook> __device__ __forceinline__ void pvT_pipe(f32x16* o, int vb, bf16x8 pa0, bf16x8 pa1, bf16x8 pa2, bf16x8 pa3, const HK& hk = HK{}) {
  constexpr int NH = 2 * NB; s16x4 fa[4], fb[4];
  pvT_half_rd<0>(vb, fa);
  pvT_step<0, NH>(o, vb, fa, fb, pa0, pa1, pa2, pa3, hk); pvT_step<1, NH>(o, vb, fb, fa, pa0, pa1, pa2, pa3, hk); pvT_step<2, NH>(o, vb, fa, fb, pa0, pa1, pa2, pa3, hk); pvT_step<3, NH>(o, vb, fb, fa, pa0, pa1, pa2, pa3, hk);
  pvT_step<4, NH>(o, vb, fa, fb, pa0, pa1, pa2, pa3, hk); pvT_step<5, NH>(o, vb, fb, fa, pa0, pa1, pa2, pa3, hk); pvT_step<6, NH>(o, vb, fa, fb, pa0, pa1, pa2, pa3, hk); pvT_step<7, NH>(o, vb, fb, fa, pa0, pa1, pa2, pa3, hk);
  if constexpr (NB == 8) {
  pvT_step<8, NH>(o, vb, fa, fb, pa0, pa1, pa2, pa3, hk); pvT_step<9, NH>(o, vb, fb, fa, pa0, pa1, pa2, pa3, hk); pvT_step<10, NH>(o, vb, fa, fb, pa0, pa1, pa2, pa3, hk); pvT_step<11, NH>(o, vb, fb, fa, pa0, pa1, pa2, pa3, hk);
  pvT_step<12, NH>(o, vb, fa, fb, pa0, pa1, pa2, pa3, hk); pvT_step<13, NH>(o, vb, fb, fa, pa0, pa1, pa2, pa3, hk); pvT_step<14, NH>(o, vb, fa, fb, pa0, pa1, pa2, pa3, hk); pvT_step<15, NH>(o, vb, fb, fa, pa0, pa1, pa2, pa3, hk); }
}
template <class HK = NoHook>
__device__ __forceinline__ void qk_mma_pipe(f32x16& p0, f32x16& p1, const bf16* Ks, const bf16x8* qr, int r32, int hi, const HK& hk = HK{}) {
  unsigned lp = (unsigned)(r32 * 256 + ((hi << 4) ^ ((r32 & 7) << 4))); asm volatile("" : "+v"(lp));
  const unsigned kb = (unsigned)(uintptr_t)Ks + lp;
#define LDKF(d0, g) (*reinterpret_cast<const __attribute__((address_space(3))) bf16x8*>((kb ^ ((unsigned)((d0) & 3) << 5)) + ((d0) >> 2) * 128 + (g) * 8192))
#define QKSTEP(D, FA0, FA1, FB0, FB1) do { if constexpr ((D) + 1 < 8) { FB0 = LDKF((D) + 1, 0); FB1 = LDKF((D) + 1, 1); } SBAR(); hk(IC<(D)>{}); SBAR(); \
    p0 = __builtin_amdgcn_mfma_f32_32x32x16_bf16(FA0, qr[D], p0, 0, 0, 0); p1 = __builtin_amdgcn_mfma_f32_32x32x16_bf16(FA1, qr[D], p1, 0, 0, 0); SBAR(); } while (0)
  bf16x8 a0 = LDKF(0, 0), a1 = LDKF(0, 1), c0, c1;
  QKSTEP(0, a0, a1, c0, c1); QKSTEP(1, c0, c1, a0, a1); QKSTEP(2, a0, a1, c0, c1); QKSTEP(3, c0, c1, a0, a1);
  QKSTEP(4, a0, a1, c0, c1); QKSTEP(5, c0, c1, a0, a1); QKSTEP(6, a0, a1, c0, c1); QKSTEP(7, c0, c1, a0, a1);
#undef QKSTEP
#undef LDKF
}
__device__ __forceinline__ void pvT_d0(f32x16* o, int vb, bf16x8 pa0, bf16x8 pa1, bf16x8 pa2, bf16x8 pa3) {
  pvT_one<0>(o[0], vb, pa0, pa1, pa2, pa3); pvT_one<1>(o[1], vb, pa0, pa1, pa2, pa3); pvT_one<2>(o[2], vb, pa0, pa1, pa2, pa3); pvT_one<3>(o[3], vb, pa0, pa1, pa2, pa3);
}

template <bool WIN, bool OUTBF>
__device__ __forceinline__ void attn_body(const bf16* __restrict__ Qb, const bf16* __restrict__ Kh, const bf16* __restrict__ Vh,
                                          void* __restrict__ Ob, int ldo, int seq, char* lds, int dq0, float nsl, float m0, float l0, int tid_in) {
  unsigned ones_ = ~0u; asm volatile("" : "+s"(ones_)); int tid_ = tid_in * 64 + (int)__builtin_amdgcn_mbcnt_hi(ones_, __builtin_amdgcn_mbcnt_lo(ones_, 0u)); asm volatile("" : "+v"(tid_));
  const int tid = tid_, wid = tid >> 6, lane = tid & 63, r32 = lane & 31, hi = lane >> 5;
  bf16* V_lds = (bf16*)lds; bf16* K_lds = (bf16*)(lds + 2 * SHM_V);
  float* ws = (float*)(lds + 2 * SHM_V + 2 * SHM_K) + wid * 64; float* li_l = ws; float* al_l = ws + 32;
  float m_reg = m0, l_reg = l0; f32x16 o[4]; bf16x8 qr[8];
  { float zf = 0.f; asm volatile("" : "+v"(zf));
    _Pragma("unroll") for (int d = 0; d < 4; ++d) _Pragma("unroll") for (int r = 0; r < 16; ++r) o[d][r] = zf; }
  const bf16* Qw = Qb + (long)(wid * QBLK + r32) * LDQ + hi * 8;
#pragma unroll
  for (int d0 = 0; d0 < 8; ++d0) qr[d0] = *reinterpret_cast<const bf16x8*>(Qw + d0 * 16);
  const float dql = (float)(dq0 + wid * QBLK + r32 - 4 * hi);
  const int sr = tid >> 4, sc = (tid & 15) * 8, vst0 = v_st(sr, sc), vst1 = v_st(32 + sr, sc);
  const int vb0 = (int)(uintptr_t)V_lds + v_rd_base(lane);
  struct { bf16x8 vs0, vs1, ks0, ks1; } sr_[ATT_SDEPTH];
#define LD8(p) (*reinterpret_cast<const bf16x8*>(p))
#define SLOAD(i, k0) do { sr_[i].vs0 = LD8(&Vh[(long)((k0) + sr) * LDK + sc]); sr_[i].vs1 = LD8(&Vh[(long)((k0) + 32 + sr) * LDK + sc]); \
    sr_[i].ks0 = LD8(&Kh[(long)((k0) + sr) * LDK + sc]); sr_[i].ks1 = LD8(&Kh[(long)((k0) + 32 + sr) * LDK + sc]); } while (0)
#define SWRITE(b, i) do { *(bf16x8*)((char*)V_lds + (b) * SHM_V + vst0) = sr_[i].vs0;          \
    *(bf16x8*)((char*)V_lds + (b) * SHM_V + vst1) = sr_[i].vs1; int kc = sc * 2;               \
    *(bf16x8*)((char*)K_lds + (b) * SHM_K + KSWZ(sr, kc)) = sr_[i].ks0;                       \
    *(bf16x8*)((char*)K_lds + (b) * SHM_K + KSWZ(32 + sr, kc)) = sr_[i].ks1; } while (0)
#define SWAIT() do { if (ATT_SDEPTH == 2) asm volatile("s_waitcnt vmcnt(4)" ::: "memory"); else asm volatile("s_waitcnt vmcnt(0)" ::: "memory"); } while (0)
#define RESC(a) do { if (__any((a) < 1.f)) { if (hi == 0) al_l[r32] = (a); asm volatile("s_waitcnt lgkmcnt(0)" ::: "memory"); \
    _Pragma("unroll") for (int d = 0; d < 4; ++d) _Pragma("unroll") for (int r = 0; r < 16; ++r) o[d][r] *= al_l[crow(r, hi)]; } } while (0)
  f32x16 pA0, pA1, pB0, pB1; float mnA, mnB, alA, alB; bf16x8 pa0, pa1, pa2, pa3; const int NT = seq / KVBLK;
  const int r0w = dq0 + __builtin_amdgcn_readfirstlane(wid) * QBLK;
  const int tlo = WIN ? (r0w - 128 < 0 ? 0 : (r0w - 128) / KVBLK) : 0, thi = WIN ? (r0w + 31 + 128) / KVBLK : 0x7fffffff;
#define TVALID(jt) ((jt) >= tlo && (jt) <= thi)
#define QKT(P0, P1, KS, jt, DQ) do { if (TVALID(jt)) qkt<WIN>(P0, P1, KS, qr, r32, hi, DQ, nsl); else { _Pragma("unroll") for (int r_ = 0; r_ < 16; ++r_) { P0[r_] = -1e30f; P1[r_] = -1e30f; } } } while (0)
#define PV(VB, jt) do { if (TVALID(jt)) pv_d0(o, VB, pa0, pa1, pa2, pa3); } while (0)
  constexpr int SE = 0, SO = ATT_SDEPTH - 1;
  SLOAD(SE, 0); asm volatile("s_waitcnt vmcnt(0)" ::: "memory"); SWRITE(0, SE); __syncthreads();
  QKT(pA0, pA1, K_lds, 0, dql); partialSM<WIN>(pA0, pA1, m_reg, mnA, alA, dql, nsl);
  SLOAD(SO, KVBLK); if (ATT_SDEPTH == 2) { if (2 < NT) SLOAD(SE, 2 * KVBLK); }
  SWAIT(); SWRITE(1, SO); __syncthreads();
  for (int j = 1; j + 1 < NT; j += 2) {
    SBAR(); QKT(pB0, pB1, (bf16*)((char*)K_lds + SHM_K), j, dql - (float)(j * KVBLK));
    finishSM(pA0, pA1, alA, l_reg, pa0, pa1, pa2, pa3); SBAR();
    SLOAD(SO, (j + ATT_SDEPTH) * KVBLK); SBAR();
    PV(vb0, j - 1); partialSM<WIN>(pB0, pB1, m_reg, mnB, alB, dql - (float)(j * KVBLK), nsl);
    __syncthreads(); SWAIT(); SWRITE(0, SE);
    RESC(alB); __syncthreads();
    SBAR(); QKT(pA0, pA1, K_lds, j + 1, dql - (float)((j + 1) * KVBLK));
    finishSM(pB0, pB1, alB, l_reg, pa0, pa1, pa2, pa3); SBAR();
    if (ATT_SDEPTH == 1 || j + 3 < NT) SLOAD(SE, (j + 1 + ATT_SDEPTH) * KVBLK); SBAR();
    PV(vb0 + (int)SHM_V, j); partialSM<WIN>(pA0, pA1, m_reg, mnA, alA, dql - (float)((j + 1) * KVBLK), nsl);
    __syncthreads(); SWAIT(); SWRITE(1, SO);
    RESC(alA); __syncthreads();
  }
  SBAR(); QKT(pB0, pB1, (bf16*)((char*)K_lds + SHM_K), NT - 1, dql - (float)((NT - 1) * KVBLK));
  finishSM(pA0, pA1, alA, l_reg, pa0, pa1, pa2, pa3); SBAR();
  PV(vb0, NT - 2); partialSM<WIN>(pB0, pB1, m_reg, mnB, alB, dql - (float)((NT - 1) * KVBLK), nsl);
  __syncthreads(); RESC(alB);
  finishSM(pB0, pB1, alB, l_reg, pa0, pa1, pa2, pa3); SBAR();
  PV(vb0 + (int)SHM_V, NT - 1);
  if (hi == 0) li_l[r32] = l_reg; asm volatile("s_waitcnt lgkmcnt(0)" ::: "memory");
  float rli[16];
#pragma unroll
  for (int r = 0; r < 16; ++r) rli[r] = __builtin_amdgcn_rcpf(li_l[crow(r, hi)]);
  if (OUTBF) { bf16* Ow = (bf16*)Ob + (long)(wid * QBLK) * ldo;
#pragma unroll
    for (int r = 0; r < 16; ++r) { const int orow = crow(r, hi);
#pragma unroll
      for (int d0 = 0; d0 < 4; ++d0) Ow[(long)orow * ldo + d0 * 32 + r32] = __float2bfloat16(o[d0][r] * rli[r]); }
  } else { float* Ow = (float*)Ob + (long)(wid * QBLK) * ldo;
#pragma unroll
    for (int r = 0; r < 16; ++r) { const int orow = crow(r, hi);
#pragma unroll
      for (int d0 = 0; d0 < 4; ++d0) Ow[(long)orow * ldo + d0 * 32 + r32] = o[d0][r] * rli[r]; }
  }
  __syncthreads();
#undef TVALID
#undef QKT
#undef PV
#undef LD8
#undef SLOAD
#undef SWRITE
#undef SWAIT
#undef RESC
}

__device__ __forceinline__ void finishSM_noexp(f32x16& p0, f32x16& p1, float& l_reg, bf16x8& pa0, bf16x8& pa1, bf16x8& pa2, bf16x8& pa3) {
  float ps = 0, ps2 = 0;
#pragma unroll
  for (int r = 0; r < 16; ++r) { ps += p0[r]; ps2 += p1[r]; }
  ps += ps2;
  { auto rr = __builtin_amdgcn_permlane32_swap(__float_as_uint(ps), __float_as_uint(ps), false, false);
    ps = __uint_as_float(rr[0]) + __uint_as_float(rr[1]); }
  l_reg += ps;
#define PK4(P, BASE, OUT) do { unsigned a0 = cvtpk(P[BASE + 0], P[BASE + 1]), a1 = cvtpk(P[BASE + 2], P[BASE + 3]);   \
    unsigned b0 = cvtpk(P[BASE + 4], P[BASE + 5]), b1 = cvtpk(P[BASE + 6], P[BASE + 7]);                              \
    auto r0 = __builtin_amdgcn_permlane32_swap(a0, b0, false, false); auto r1 = __builtin_amdgcn_permlane32_swap(a1, b1, false, false); \
    u32x4 w = {r0[0], r1[0], r0[1], r1[1]}; OUT = *reinterpret_cast<bf16x8*>(&w); } while (0)
  PK4(p0, 0, pa0); PK4(p0, 8, pa1); PK4(p1, 0, pa2); PK4(p1, 8, pa3);
#undef PK4
}
template <class HK = NoHook>
__device__ __forceinline__ void qkt_diff(f32x16& p0, f32x16& p1, const bf16* Ks, const bf16x8* qr, int r32, int hi, bool diag, float sg, float base, float dqh, float nsl, float mref, const HK& hk = HK{}) {
  if (diag) {
#pragma unroll
    for (int r = 0; r < 16; ++r) { p0[r] = fmaf(nsl, fabsf(dqh - (float)((r & 3) + 8 * (r >> 2))), -mref); p1[r] = fmaf(nsl, fabsf(dqh - (float)(32 + (r & 3) + 8 * (r >> 2))), -mref); }
  } else {
#pragma unroll
    for (int r = 0; r < 16; ++r) { p0[r] = fmaf(sg, (float)((r & 3) + 8 * (r >> 2)), base); p1[r] = fmaf(sg, (float)(32 + (r & 3) + 8 * (r >> 2)), base); }
  }
  qk_mma_pipe(p0, p1, Ks, qr, r32, hi, hk);
}
#define MX3(a, b, c) __builtin_fmaxf(__builtin_fmaxf((a), (b)), (c))
constexpr size_t SHM_DIFF = 3 * (2 * SHM_V) + 3 * SHM_K + NW * 64 * 4;
template <bool SECOND>
__device__ __forceinline__ void attn_diff_body(const bf16* __restrict__ Qb, const bf16* __restrict__ Kh, const bf16* __restrict__ Vh, float* Scr, bf16* Yd, int ldy,
                                               char* lds, int dq0, float nsl, float lam, float oscale, const float* __restrict__ g, int seq, int tid_in) {
  unsigned ones_ = ~0u; asm volatile("" : "+s"(ones_)); int tid_ = tid_in * 64 + (int)__builtin_amdgcn_mbcnt_hi(ones_, __builtin_amdgcn_mbcnt_lo(ones_, 0u)); asm volatile("" : "+v"(tid_));
  const int tid = tid_, wid = tid >> 6, lane = tid & 63, r32 = lane & 31, hi = lane >> 5;
  bf16* V_lds = (bf16*)lds; bf16* K_lds = (bf16*)(lds + 6 * SHM_V);
  float* al_l = (float*)(lds + 6 * SHM_V + 3 * SHM_K) + __builtin_amdgcn_readfirstlane(wid) * 64 + 32;
  float mref = 0.f, l_reg = 0.f; f32x16 o[8]; bf16x8 qr[8];
  { float zf = 0.f; asm volatile("" : "+v"(zf));
    _Pragma("unroll") for (int d = 0; d < 8; ++d) _Pragma("unroll") for (int r = 0; r < 16; ++r) o[d][r] = zf; }
  const bf16* Qw = Qb + (long)(wid * QBLK + r32) * LDQ + hi * 8;
#pragma unroll
  for (int d0 = 0; d0 < 8; ++d0) qr[d0] = *reinterpret_cast<const bf16x8*>(Qw + d0 * 16);
  const float dql = (float)(dq0 + wid * QBLK + r32 - 4 * hi);
  int vb0 = (int)(uintptr_t)V_lds + v_rd_base(lane); asm volatile("" : "+v"(vb0));
  const int widu = __builtin_amdgcn_readfirstlane(wid);
  const unsigned lds0 = (unsigned)(uintptr_t)lds;
#define GLDS(src, ldsoff) __builtin_amdgcn_global_load_lds((const unsigned*)(src), (__attribute__((address_space(3))) unsigned*)(unsigned)(ldsoff), 16, 0, 0)
#define STAGE(k0, b) do { const bf16* kt = Kh + (long)(k0) * LDK; const bf16* vt = Vh + (long)(k0) * LDK; \
    _Pragma("unroll") for (int q = 0; q < 2; ++q) { const int row = (wid * 2 + q) * 4 + (lane >> 4), c = (lane & 15) ^ (row & 7); \
      GLDS(kt + row * LDK + c * 8, lds0 + 6 * (unsigned)SHM_V + (b) * (unsigned)SHM_K + (widu * 2 + q) * 1024); } \
    _Pragma("unroll") for (int q = 0; q < 4; ++q) { const int ob = (wid * 4 + q) * 1024 + lane * 16, img = ob >> 14, oi = ob & 16383, st = oi >> 9, w = oi & 511; \
      const int kk = (st >> 2) * 8 + (w >> 6), k = (kk & ~0xC) | ((kk & 4) << 1) | ((kk & 8) >> 1), c = (st & 3) * 32 + ((w & 63) >> 1); \
      GLDS(vt + k * LDK + img * 128 + c, lds0 + (b) * 2 * (unsigned)SHM_V + (widu * 4 + q) * 1024); } } while (0)
  int lane_s = lane;
#define STAGE_K(k0, b, q) do { const bf16* kt = Kh + (long)(k0) * LDK; const int row = (widu * 2 + (q)) * 4 + (lane_s >> 4), c = (lane_s & 15) ^ (row & 7); \
      GLDS(kt + row * LDK + c * 8, lds0 + 6 * (unsigned)SHM_V + (b) * (unsigned)SHM_K + (widu * 2 + (q)) * 1024); } while (0)
#define STAGE_V(k0, b, q) do { const bf16* vt = Vh + (long)(k0) * LDK; const int ob = (widu * 4 + (q)) * 1024 + lane_s * 16, img = ob >> 14, oi = ob & 16383, st = oi >> 9, w = oi & 511; \
      const int kk = (st >> 2) * 8 + (w >> 6), k = (kk & ~0xC) | ((kk & 4) << 1) | ((kk & 8) >> 1), c = (st & 3) * 32 + ((w & 63) >> 1); \
      GLDS(vt + k * LDK + img * 128 + c, lds0 + (b) * 2 * (unsigned)SHM_V + (widu * 4 + (q)) * 1024); } while (0)
  f32x16 sA0, sA1, sB0, sB1; bf16x8 paA0, paA1, paA2, paA3, paB0, paB1, paB2, paB3; const int NT = seq / KVBLK;
  float mxa = 0.f, mxc = 0.f, psum = 0.f; bool resc = false;
#define SM_PIECE(I, S0, S1, Q0, Q1, Q2, Q3) do { \
    if constexpr (I == 1) { mxa = MX3(S0[0], S0[1], S1[0]); mxc = MX3(S0[2], S0[3], S1[1]); mxa = MX3(mxa, S1[2], S1[3]); mxa = MX3(mxa, S0[4], S0[5]); mxc = MX3(mxc, S0[6], S0[7]); mxa = MX3(mxa, S1[4], S1[5]); mxc = MX3(mxc, S1[6], S1[7]); } \
    else if constexpr (I == 2) { mxa = MX3(mxa, S0[8], S0[9]); mxc = MX3(mxc, S0[10], S0[11]); mxa = MX3(mxa, S1[8], S1[9]); mxc = MX3(mxc, S1[10], S1[11]); mxa = MX3(mxa, S0[12], S0[13]); mxc = MX3(mxc, S0[14], S0[15]); mxa = MX3(mxa, S1[12], S1[13]); mxc = MX3(mxc, S1[14], S1[15]); } \
    else if constexpr (I == 3) { float pmax = __builtin_fmaxf(mxa, mxc); psum = 0.f; \
        { auto rr = __builtin_amdgcn_permlane32_swap(__float_as_uint(pmax), __float_as_uint(pmax), false, false); pmax = __builtin_fmaxf(__uint_as_float(rr[0]), __uint_as_float(rr[1])); } \
        if (__builtin_expect(!__all(pmax <= THR2), 0)) {                   \
          const float dl = __builtin_fmaxf(pmax, 0.f); mref += dl; const float al_ = __builtin_amdgcn_exp2f(-dl); l_reg *= al_; { int rr_ = r32; asm volatile("" : "+v"(rr_)); al_l[rr_] = al_; } resc = true;     \
          _Pragma("unroll") for (int r = 0; r < 16; ++r) { S0[r] -= dl; S1[r] -= dl; } } } \
    else if constexpr (I >= 4 && I <= 7) { constexpr int B_ = (I - 4) * 4; _Pragma("unroll") for (int r = 0; r < 4; ++r) S0[B_ + r] = __builtin_amdgcn_exp2f(S0[B_ + r]); \
        if constexpr (I > 4) psum += (S0[B_ - 4] + S0[B_ - 3]) + (S0[B_ - 2] + S0[B_ - 1]); } \
    else if constexpr (I >= 8 && I <= 11) { constexpr int B_ = (I - 8) * 4; _Pragma("unroll") for (int r = 0; r < 4; ++r) S1[B_ + r] = __builtin_amdgcn_exp2f(S1[B_ + r]); \
        if constexpr (I == 8) psum += (S0[12] + S0[13]) + (S0[14] + S0[15]); else psum += (S1[B_ - 4] + S1[B_ - 3]) + (S1[B_ - 2] + S1[B_ - 1]); } \
    else if constexpr (I == 12) { psum += (S1[12] + S1[13]) + (S1[14] + S1[15]); \
        { auto rr = __builtin_amdgcn_permlane32_swap(__float_as_uint(psum), __float_as_uint(psum), false, false); psum = __uint_as_float(rr[0]) + __uint_as_float(rr[1]); } l_reg += psum; DPK4(S0, 0, Q0); } \
    else if constexpr (I == 13) { DPK4(S0, 8, Q1); } \
    else if constexpr (I == 14) { DPK4(S1, 0, Q2); } \
    else if constexpr (I == 15) { DPK4(S1, 8, Q3); } } while (0)
#define DPK4(P, BASE, OUT) do { unsigned a0 = cvtpk(P[BASE + 0], P[BASE + 1]), a1 = cvtpk(P[BASE + 2], P[BASE + 3]);   \
    unsigned b0 = cvtpk(P[BASE + 4], P[BASE + 5]), b1 = cvtpk(P[BASE + 6], P[BASE + 7]);                              \
    auto r0 = __builtin_amdgcn_permlane32_swap(a0, b0, false, false); auto r1 = __builtin_amdgcn_permlane32_swap(a1, b1, false, false); \
    u32x4 w = {r0[0], r1[0], r0[1], r1[1]}; OUT = *reinterpret_cast<bf16x8*>(&w); } while (0)
#define QK_TILE(T, KB, S0, S1, HK) do { const int dw = dq0 + widu * QBLK - (T) * KVBLK;        \
      const bool diag = (dw > -32) && (dw < 64); const float sgn = dw >= 64 ? 1.f : -1.f; const float dqh = dql - (float)((T) * KVBLK); \
      qkt_diff(S0, S1, (bf16*)((char*)K_lds + (KB) * SHM_K), qr, r32, hi, diag, -nsl * sgn, fmaf(nsl * sgn, dqh, -mref), dqh, nsl, mref, HK); } while (0)
#define ITER_HEAD(J) const int j_ = (J); lane_s = lane; asm volatile("" : "+v"(lane_s)); \
    const int kk3 = (j_ + 3 < NT ? j_ + 3 : NT - 1) * KVBLK, kv2 = (j_ + 2 < NT ? j_ + 2 : NT - 1) * KVBLK; \
    auto dmahk = [&](auto ic) { constexpr int I = decltype(ic)::v;     \
      if constexpr (I == 0) { STAGE_K(kk3, b, 0); } else if constexpr (I == 1) { STAGE_K(kk3, b, 1); } else if constexpr (I == 2) { STAGE_V(kv2, b2, 0); } \
      else if constexpr (I == 3) { STAGE_V(kv2, b2, 1); } else if constexpr (I == 4) { STAGE_V(kv2, b2, 2); } else if constexpr (I == 5) { STAGE_V(kv2, b2, 3); } }; \
    SBAR();
#define ITER_TAIL() \
    asm volatile("s_waitcnt vmcnt(6)" ::: "memory");            \
    __builtin_amdgcn_s_barrier(); SBAR(); \
    b = b1; b1 = b2; b2 = (b2 == 2) ? 0 : b2 + 1;
#define ITER(J, X0, X1, X2, X3, Y0, Y1, Z0, Z1, Z2, Z3) do { ITER_HEAD(J) \
    QK_TILE(j_ + 1, b1, Y0, Y1, dmahk); \
    SBAR(); resc = false; \
    __builtin_amdgcn_s_setprio(1); \
    { auto hk = [&](auto ic) { constexpr int I = decltype(ic)::v; if constexpr (I >= 1) { SM_PIECE(I, Y0, Y1, Z0, Z1, Z2, Z3); SBAR(); } }; \
      pvT_pipe<8>(o, vb0 + b * 2 * (int)SHM_V, X0, X1, X2, X3, hk); } \
    __builtin_amdgcn_s_setprio(0); \
    SBAR(); \
    if (__builtin_expect(resc, 0)) { int rr_ = r32; asm volatile("" : "+v"(rr_)); const float al_ = al_l[rr_]; _Pragma("unroll") for (int d = 0; d < 8; ++d) _Pragma("unroll") for (int r = 0; r < 16; ++r) o[d][r] *= al_; }     \
    ITER_TAIL() } while (0)
#define ITER_LAST(J, X0, X1, X2, X3) do { ITER_HEAD(J) \
    dmahk(IC<0>{}); dmahk(IC<1>{}); dmahk(IC<2>{}); dmahk(IC<3>{}); dmahk(IC<4>{}); dmahk(IC<5>{}); SBAR(); \
    __builtin_amdgcn_s_setprio(1); pvT_pipe<8>(o, vb0 + b * 2 * (int)SHM_V, X0, X1, X2, X3); __builtin_amdgcn_s_setprio(0); SBAR(); \
    ITER_TAIL() } while (0)
  STAGE_K(0, 0, 0); STAGE_K(0, 0, 1); STAGE_K(KVBLK, 1, 0); STAGE_K(KVBLK, 1, 1); STAGE_K(2 * KVBLK, 2, 0); STAGE_K(2 * KVBLK, 2, 1);
  STAGE_V(0, 0, 0); STAGE_V(0, 0, 1); STAGE_V(0, 0, 2); STAGE_V(0, 0, 3); STAGE_V(KVBLK, 1, 0); STAGE_V(KVBLK, 1, 1); STAGE_V(KVBLK, 1, 2); STAGE_V(KVBLK, 1, 3);
  asm volatile("s_waitcnt vmcnt(0)" ::: "memory"); __builtin_amdgcn_s_barrier(); SBAR();
  int b = 0, b1 = 1, b2 = 2;
  QK_TILE(0, 0, sA0, sA1, NoHook{});
  SM_PIECE(1, sA0, sA1, paA0, paA1, paA2, paA3); SM_PIECE(2, sA0, sA1, paA0, paA1, paA2, paA3); SM_PIECE(3, sA0, sA1, paA0, paA1, paA2, paA3); SM_PIECE(4, sA0, sA1, paA0, paA1, paA2, paA3);
  SM_PIECE(5, sA0, sA1, paA0, paA1, paA2, paA3); SM_PIECE(6, sA0, sA1, paA0, paA1, paA2, paA3); SM_PIECE(7, sA0, sA1, paA0, paA1, paA2, paA3); SM_PIECE(8, sA0, sA1, paA0, paA1, paA2, paA3);
  SM_PIECE(9, sA0, sA1, paA0, paA1, paA2, paA3); SM_PIECE(10, sA0, sA1, paA0, paA1, paA2, paA3); SM_PIECE(11, sA0, sA1, paA0, paA1, paA2, paA3); SM_PIECE(12, sA0, sA1, paA0, paA1, paA2, paA3);
  SM_PIECE(13, sA0, sA1, paA0, paA1, paA2, paA3); SM_PIECE(14, sA0, sA1, paA0, paA1, paA2, paA3); SM_PIECE(15, sA0, sA1, paA0, paA1, paA2, paA3);
  for (int j = 0; j < NT - 2; j += 2) {
    ITER(j, paA0, paA1, paA2, paA3, sB0, sB1, paB0, paB1, paB2, paB3);
    ITER(j + 1, paB0, paB1, paB2, paB3, sA0, sA1, paA0, paA1, paA2, paA3);
  }
  ITER(NT - 2, paA0, paA1, paA2, paA3, sB0, sB1, paB0, paB1, paB2, paB3);
  ITER_LAST(NT - 1, paB0, paB1, paB2, paB3);
#undef ITER
#undef ITER_LAST
#undef ITER_HEAD
#undef ITER_TAIL
#undef QK_TILE
#undef SM_PIECE
#undef DPK4
  asm volatile("s_waitcnt vmcnt(0)" ::: "memory");
  if (SECOND) { __builtin_amdgcn_s_barrier(); SBAR(); }
  const float rl = __builtin_amdgcn_rcpf(l_reg);
  int lane_e = lane; asm volatile("" : "+v"(lane_e));
  const int r32e = lane_e & 31, hie = lane_e >> 5;
  f32x4* sw4 = (f32x4*)(Scr + (size_t)widu * (16 * 8 * 64)) + lane_e;
  if (!SECOND) {
#pragma unroll
    for (int d0 = 0; d0 < 8; ++d0)
#pragma unroll
      for (int g4 = 0; g4 < 4; ++g4) sw4[(d0 * 4 + g4) * 64] = (f32x4){o[d0][4 * g4] * rl, o[d0][4 * g4 + 1] * rl, o[d0][4 * g4 + 2] * rl, o[d0][4 * g4 + 3] * rl};
  } else {
    float ss = 0.f; const float lr = lam * rl;
#pragma unroll
    for (int d0 = 0; d0 < 8; ++d0)
#pragma unroll
      for (int g4 = 0; g4 < 4; ++g4) { const f32x4 a4 = sw4[(d0 * 4 + g4) * 64];
#pragma unroll
        for (int k = 0; k < 4; ++k) { const float dv = a4[k] - lr * o[d0][4 * g4 + k]; o[d0][4 * g4 + k] = dv; ss += dv * dv; } }
    { auto rr = __builtin_amdgcn_permlane32_swap(__float_as_uint(ss), __float_as_uint(ss), false, false); ss = __uint_as_float(rr[0]) + __uint_as_float(rr[1]); }
    const float rs = (1.f / sqrtf(ss * (1.f / 256.f) + 1e-5f)) * oscale;
    char* stg = lds + widu * (32 * 528) + r32e * 528 + 8 * hie;
#pragma unroll
    for (int d0 = 0; d0 < 8; ++d0)
#pragma unroll
      for (int g4 = 0; g4 < 4; ++g4) { const f32x4 gg = *(const f32x4*)(g + d0 * 32 + g4 * 8 + 4 * hie);
        uint2 w; w.x = cvtpk(o[d0][4 * g4] * rs * gg[0], o[d0][4 * g4 + 1] * rs * gg[1]); w.y = cvtpk(o[d0][4 * g4 + 2] * rs * gg[2], o[d0][4 * g4 + 3] * rs * gg[3]);
        *(uint2*)(stg + (d0 * 32 + g4 * 8) * 2) = w; }
    const char* rd = lds + widu * (32 * 528) + (lane_e >> 5) * 528 + (lane_e & 31) * 16;
    char* yo = (char*)(Yd + (long)(widu * QBLK + (lane_e >> 5)) * ldy) + (lane_e & 31) * 16;
#pragma unroll
    for (int i = 0; i < 16; ++i) { const u32x4 x = *(const u32x4*)(rd + i * (2 * 528)); *(u32x4*)(yo + (long)i * 2 * ldy * 2) = x; }
  }
  __syncthreads();
#undef GLDS
#undef STAGE
#undef STAGE_K
#undef STAGE_V
}

constexpr size_t SHM_WIN = 3 * SHM_V + 3 * SHM_K + NW * 64 * 4;
__device__ __forceinline__ void attn_win_body(const bf16* __restrict__ Qb, const bf16* __restrict__ Kh, const bf16* __restrict__ Vh, bf16* __restrict__ Ob, int ldo,
                                              char* lds, int dq0, float nsl, float sink_l2, int seq, int tid_in) {
  unsigned ones_ = ~0u; asm volatile("" : "+s"(ones_)); int tid_ = tid_in * 64 + (int)__builtin_amdgcn_mbcnt_hi(ones_, __builtin_amdgcn_mbcnt_lo(ones_, 0u)); asm volatile("" : "+v"(tid_));
  const int tid = tid_, wid = tid >> 6, lane = tid & 63, r32 = lane & 31, hi = lane >> 5;
  bf16* V_lds = (bf16*)lds; bf16* K_lds = (bf16*)(lds + 3 * SHM_V);
  float* ws = (float*)(lds + 3 * SHM_V + 3 * SHM_K) + wid * 64; float* li_l = ws; float* al_l = ws + 32;
  float mref = 0.f, l_reg = __builtin_amdgcn_exp2f(sink_l2); f32x16 o[4]; bf16x8 qr[8];
  { float zf = 0.f; asm volatile("" : "+v"(zf));
    _Pragma("unroll") for (int d = 0; d < 4; ++d) _Pragma("unroll") for (int r = 0; r < 16; ++r) o[d][r] = zf; }
  const bf16* Qw = Qb + (long)(wid * QBLK + r32) * LDQ + hi * 8;
#pragma unroll
  for (int d0 = 0; d0 < 8; ++d0) qr[d0] = *reinterpret_cast<const bf16x8*>(Qw + d0 * 16);
  const float dql = (float)(dq0 + wid * QBLK + r32 - 4 * hi);
  const int vb0 = (int)(uintptr_t)V_lds + v_rd_base(lane);
  const int widu = __builtin_amdgcn_readfirstlane(wid);
  const unsigned lds0 = (unsigned)(uintptr_t)lds;
  const int r0w = dq0 + widu * QBLK;
  const int tlo = r0w - 128 < 0 ? 0 : (r0w - 128) / KVBLK, thi = (r0w + 31 + 128) / KVBLK;
#define GLDS(src, ldsoff) __builtin_amdgcn_global_load_lds((const unsigned*)(src), (__attribute__((address_space(3))) unsigned*)(unsigned)(ldsoff), 16, 0, 0)
#define STAGE(k0, b) do { const bf16* kt = Kh + (long)(k0) * LDK; const bf16* vt = Vh + (long)(k0) * LDK; \
    _Pragma("unroll") for (int q = 0; q < 2; ++q) { const int row = (wid * 2 + q) * 4 + (lane >> 4), c = (lane & 15) ^ (row & 7); \
      GLDS(kt + row * LDK + c * 8, lds0 + 3 * (unsigned)SHM_V + (b) * (unsigned)SHM_K + (widu * 2 + q) * 1024); } \
    _Pragma("unroll") for (int q = 0; q < 2; ++q) { const int oi = (wid * 2 + q) * 1024 + lane * 16, st = oi >> 9, w = oi & 511; \
      const int kk = (st >> 2) * 8 + (w >> 6), k = (kk & ~0xC) | ((kk & 4) << 1) | ((kk & 8) >> 1), c = (st & 3) * 32 + ((w & 63) >> 1); \
      GLDS(vt + k * LDK + c, lds0 + (b) * (unsigned)SHM_V + (widu * 2 + q) * 1024); } } while (0)
  f32x16 p0, p1; float al; bf16x8 pa0, pa1, pa2, pa3; const int NT = seq / KVBLK;
  STAGE(0, 0); STAGE(KVBLK, 1); asm volatile("s_waitcnt vmcnt(4)" ::: "memory"); __builtin_amdgcn_s_barrier(); SBAR();
  int b = 0, b2 = 2;
  for (int j = 0; j < NT; ++j) {
    if (j + 2 < NT) STAGE((j + 2) * KVBLK, b2);
    SBAR();
    if (j >= tlo && j <= thi) {
      const float dqh = dql - (float)(j * KVBLK);
#pragma unroll
      for (int r = 0; r < 16; ++r) { const float d0_ = fabsf(dqh - (float)((r & 3) + 8 * (r >> 2))), d1_ = fabsf(dqh - (float)(32 + (r & 3) + 8 * (r >> 2)));
        p0[r] = d0_ <= 128.f ? fmaf(nsl, d0_, -mref) : -1e30f; p1[r] = d1_ <= 128.f ? fmaf(nsl, d1_, -mref) : -1e30f; }
      qk_mma_pipe(p0, p1, (const bf16*)((const char*)K_lds + b * SHM_K), qr, r32, hi);
      { float a = MX3(p0[0], p0[1], p1[0]), c = MX3(p0[2], p0[3], p1[1]); a = MX3(a, p1[2], p1[3]);
#pragma unroll
        for (int r = 4; r < 16; r += 4) { a = MX3(a, p0[r], p0[r + 1]); c = MX3(c, p0[r + 2], p0[r + 3]); a = MX3(a, p1[r], p1[r + 1]); c = MX3(c, p1[r + 2], p1[r + 3]); }
        float pmax = __builtin_fmaxf(a, c);
        { auto rr = __builtin_amdgcn_permlane32_swap(__float_as_uint(pmax), __float_as_uint(pmax), false, false); pmax = __builtin_fmaxf(__uint_as_float(rr[0]), __uint_as_float(rr[1])); }
        if (__builtin_expect(!__all(pmax <= THR2), 0)) {
          const float dl = __builtin_fmaxf(pmax, 0.f); mref += dl; al = __builtin_amdgcn_exp2f(-dl); l_reg *= al;
#pragma unroll
          for (int r = 0; r < 16; ++r) { p0[r] -= dl; p1[r] -= dl; }
#pragma unroll
          for (int d = 0; d < 4; ++d)
#pragma unroll
            for (int r = 0; r < 16; ++r) o[d][r] *= al; }
#pragma unroll
        for (int r = 0; r < 16; ++r) { p0[r] = __builtin_amdgcn_exp2f(p0[r]); p1[r] = __builtin_amdgcn_exp2f(p1[r]); } }
      finishSM_noexp(p0, p1, l_reg, pa0, pa1, pa2, pa3);
      SBAR();
      pvT_pipe<4>(o, vb0 + b * (int)SHM_V, pa0, pa1, pa2, pa3);
    }
    SBAR();
    if (j + 2 < NT) asm volatile("s_waitcnt vmcnt(4)" ::: "memory"); else asm volatile("s_waitcnt vmcnt(0)" ::: "memory");
    __builtin_amdgcn_s_barrier(); SBAR();
    b = (b == 2) ? 0 : b + 1; b2 = (b2 == 2) ? 0 : b2 + 1;
  }
  const float rl = __builtin_amdgcn_rcpf(l_reg);
  { char* stg = lds + widu * (32 * 272) + r32 * 272 + 8 * hi;
#pragma unroll
    for (int d0 = 0; d0 < 4; ++d0)
#pragma unroll
      for (int g4 = 0; g4 < 4; ++g4) { uint2 w; w.x = cvtpk(o[d0][4 * g4] * rl, o[d0][4 * g4 + 1] * rl); w.y = cvtpk(o[d0][4 * g4 + 2] * rl, o[d0][4 * g4 + 3] * rl);
        *(uint2*)(stg + (d0 * 32 + g4 * 8) * 2) = w; }
    const char* rd = lds + widu * (32 * 272) + (lane >> 4) * 272 + (lane & 15) * 16;
    char* yo = (char*)(Ob + (long)(widu * QBLK + (lane >> 4)) * ldo) + (lane & 15) * 16;
#pragma unroll
    for (int i = 0; i < 8; ++i) { const u32x4 x = *(const u32x4*)(rd + i * (4 * 272)); *(u32x4*)(yo + (long)i * 4 * ldo * 2) = x; } }
  __syncthreads();
#undef GLDS
#undef STAGE
}
#undef SBAR
#undef KSWZ
}

#define GAS __attribute__((address_space(1)))
#define LAS __attribute__((address_space(3)))
typedef unsigned short bf16;
typedef unsigned v4u __attribute__((ext_vector_type(4)));
typedef float f32x4 __attribute__((ext_vector_type(4)));
typedef short bf16x8 __attribute__((ext_vector_type(8)));
typedef GAS unsigned gu32;
typedef GAS unsigned long long gu64;
#define RLX_AGENT __ATOMIC_RELAXED, __HIP_MEMORY_SCOPE_AGENT
#define LDS_WAIT() asm volatile("s_waitcnt lgkmcnt(0)" ::: "memory")
#define VM_WAIT() asm volatile("s_waitcnt vmcnt(0)" ::: "memory")
__device__ __forceinline__ unsigned long long rt() { return __builtin_amdgcn_s_memrealtime(); }
__device__ __forceinline__ unsigned f2bf(float f) { unsigned u = __builtin_bit_cast(unsigned, f); return (u + 0x7fffu + ((u >> 16) & 1u)) >> 16; }
__device__ __forceinline__ unsigned pk2(float lo, float hi) { return f2bf(lo) | (f2bf(hi) << 16); }

#define XB_TMO      128
#define XB_XCNT(j)  (256  + 64 * (j))
#define XB_XSUB(j)  (1280 + 64 * (j))
#define XB_XGEN(j)  (2304 + 64 * (j))
#define XB_TOP      3328
#define XB_TOPGEN   3392
#define XCD_BAR_WORDS 3456
#define XB_SPIN_CAP (1u << 18)

__device__ __forceinline__ unsigned xb_ld(unsigned* p)              { return __hip_atomic_load(p, __ATOMIC_RELAXED, __HIP_MEMORY_SCOPE_AGENT); }
__device__ __forceinline__ unsigned xb_add(unsigned* p, unsigned v) { return __hip_atomic_fetch_add(p, v, __ATOMIC_RELAXED, __HIP_MEMORY_SCOPE_AGENT); }
__device__ __forceinline__ unsigned xb_xcc_id() { return (unsigned)__builtin_amdgcn_s_getreg((3 << 11) | 20) & 0xFu; }
#define XB_SPIN(cond, bar) do { unsigned _sp = 0; while (cond) { __builtin_amdgcn_s_sleep(1); \
    if ((++_sp & 255u) == 0u) { if (xb_ld(&(bar)[XB_TMO])) break; if (_sp > XB_SPIN_CAP) { atomicAdd(&(bar)[XB_TMO], 1u); break; } } } } while (0)

struct XcdBarrier {
    unsigned* bar; unsigned x;
    volatile LAS unsigned* st;
};

__device__ __forceinline__ XcdBarrier xcd_barrier_post(unsigned* bar, volatile LAS unsigned* st) {
    XcdBarrier b; b.bar = bar; b.x = xb_xcc_id(); b.st = st;
    if (threadIdx.x == 0) (void)xb_add(&bar[XB_XCNT(b.x)], 1u);
    return b;
}
__device__ __forceinline__ void xcd_barrier_complete(unsigned* bar, unsigned x, unsigned& nloc, unsigned& nx) {
    const unsigned G = gridDim.x * gridDim.y * gridDim.z;
    unsigned sum, cnt, mine, sp = 0u;
    for (;;) {
        sum = 0u; cnt = 0u; mine = 0u;
#pragma unroll
        for (unsigned j = 0; j < 16; ++j) { const unsigned c = xb_ld(&bar[XB_XCNT(j)]); sum += c; cnt += (c > 0u) ? 1u : 0u; mine = (j == x) ? c : mine; }
        if (sum == G) break;
        __builtin_amdgcn_s_sleep(1);
        if ((++sp & 255u) == 0u) { if (xb_ld(&bar[XB_TMO])) break; if (sp > XB_SPIN_CAP) { atomicAdd(&bar[XB_TMO], 1u); break; } }
    }
    nloc = mine > 0u ? mine : 1u; nx = cnt > 0u ? cnt : 1u;
}

__device__ __forceinline__ void xcd_barrier(const XcdBarrier& b) {
    asm volatile("s_waitcnt vmcnt(0)" ::: "memory");
    __syncthreads();
    if (threadIdx.x == 0) {
        unsigned* bar = b.bar;
        __builtin_amdgcn_s_waitcnt(0);
        unsigned nloc = b.st[0], nx = b.st[1];
        if (nloc == 0u) { xcd_barrier_complete(bar, b.x, nloc, nx); b.st[0] = nloc; b.st[1] = nx; }
        const unsigned old = xb_add(&bar[XB_XSUB(b.x)], 1u);
        const unsigned gen = old / nloc;
        if (old + 1u == (gen + 1u) * nloc) {
            __builtin_amdgcn_fence(__ATOMIC_RELEASE, "agent");
            asm volatile("s_waitcnt vmcnt(0)" ::: "memory");
            const unsigned og = xb_add(&bar[XB_TOP], 1u);
            const unsigned tg = og / nx;
            if (og + 1u == (tg + 1u) * nx) xb_add(&bar[XB_TOPGEN], 1u);
            else XB_SPIN(xb_ld(&bar[XB_TOPGEN]) == tg, bar);
            __builtin_amdgcn_fence(__ATOMIC_ACQUIRE, "agent");
            xb_add(&bar[XB_XGEN(b.x)], 1u);
            asm volatile("s_waitcnt vmcnt(0)" ::: "memory");
        } else {
            XB_SPIN(xb_ld(&bar[XB_XGEN(b.x)]) == gen, bar);
            __builtin_amdgcn_fence(__ATOMIC_ACQUIRE, "agent");
            asm volatile("s_waitcnt vmcnt(0)" ::: "memory");
        }
    }
    __syncthreads();
}

constexpr int NWAVES = 8;
constexpr int DM = 2048, SEQ = 2048, DEPTH = 4, CSEQ = 8, TC = CSEQ * SEQ, NCHUNK = 3, TPROMPT = 16 * SEQ, TTOT = 24 * SEQ;
constexpr int INC = 8704, DFF = 5504, NEXP = 8, DFE = 1024;
constexpr int ZQA = 0, ZKA = 1024, ZVA = 1280, ZQD = 1536, ZKD = 2560, ZVD = 3584, ZGA = 4608;
constexpr float LN_EPS = 1e-5f, ALPHA = 1.681792830507429f;
constexpr int SROWS = SEQ, SEGS = SROWS / 64, NSEQ_ALL = TTOT / SEQ, MAXGRP = 8;
constexpr int SLOTS_G = 2 * SROWS + NEXP * 256;
#define SEGROW(seg, w, i) (256 * ((seg) & 7) + 64 * ((seg) >> 3) + 8 * (w) + (i))
#ifndef FP8_DENSE_UP
#define FP8_DENSE_UP 1
#endif
#ifndef FP8_DENSE_DOWN
#define FP8_DENSE_DOWN 1
#endif
#ifndef FP8_MOE_UP
#define FP8_MOE_UP 1
#endif
#ifndef FP8_MOE_DOWN
#define FP8_MOE_DOWN 1
#endif
#ifndef FP8_INPROJ_QKV
#define FP8_INPROJ_QKV 0
#endif
constexpr float W8_SCALE = 128.f, U8_SCALE = 16.f;
constexpr float LO8_SCALE = 4096.f;
#ifndef FP8_INPROJ_GATES
#define FP8_INPROJ_GATES 1
#endif
constexpr size_t WL_WING8 = 18u << 20;
constexpr size_t WL_WING = 9u << 20;
constexpr int DFF8 = 5632;
static_assert(FP8_DENSE_UP && FP8_DENSE_DOWN && FP8_MOE_UP && FP8_MOE_DOWN && FP8_INPROJ_GATES && !FP8_INPROJ_QKV, "the per-group arena map below is laid out for this precision choice");

constexpr size_t MiB = 1u << 20;
constexpr size_t WS_CTL = 0, CTL_ZERO_BYTES = 1 * MiB;
constexpr size_t WS_WL = 2 * MiB, WL_STRIDE = 50 * MiB, WL_WIN = 0, WL_WPAD = 34 * MiB, WL_WO = 42 * MiB;
constexpr size_t WS_WD = 202 * MiB, WD_STRIDE = 64 * MiB + MiB / 2, WD_W13 = 0, WD_W2 = 43 * MiB;
constexpr size_t WS_WM = 331 * MiB, WM_STRIDE = 96 * MiB, WM_W13 = 0, WM_W2 = 64 * MiB;
static_assert((size_t)INC * DM * 2 <= 34 * MiB && (size_t)2 * DFF * DM * 2 <= 43 * MiB && (size_t)DM * DFF * 2 <= WD_STRIDE - WD_W2, "weight map");
static_assert(WS_WD + 2 * WD_STRIDE <= WS_WM && WS_WM + 2 * WM_STRIDE <= 524 * MiB, "weight map");
constexpr size_t WS_ARENA = 524 * MiB, ARENA = 86 * MiB;
constexpr size_t A_XB = 0, A_XLO = 8 * MiB, A_XB8 = 12 * MiB, A_Z = 16 * MiB, A_YAD = 50 * MiB, A_MERGED = 58 * MiB, A_MIX = 66 * MiB, A_U8 = 74 * MiB, A_SMALL = 85 * MiB;
constexpr size_t A_HBG = A_Z, A_UM = A_Z + 12 * MiB, A_OM = A_YAD;
constexpr size_t A_ROUTE = A_SMALL, A_TOKSLOT = A_ROUTE + (size_t)SROWS * 16, A_SLOTGATE = A_TOKSLOT + (size_t)SROWS * 8, A_SEGCNT = A_SLOTGATE + (size_t)SLOTS_G * 4, A_MOEOFF = A_SEGCNT + (size_t)SEGS * 8 * 4;
static_assert(A_MOEOFF + 64 <= ARENA && (size_t)SROWS * INC * 2 <= A_YAD - A_Z && (size_t)SLOTS_G * DM + (size_t)SLOTS_G * DFE <= A_YAD - A_Z && (size_t)SLOTS_G * DM * 2 <= A_U8 - A_YAD && (size_t)SROWS * 5632 <= A_SMALL - A_U8, "arena map");
constexpr size_t WS_SCR = WS_ARENA + MAXGRP * ARENA, WS_END = WS_SCR + 64 * MiB;
constexpr int CW_TMO = 0, CW_BAR = 4096;

constexpr int RING_OFF = 0, RING_BYTES = 151552;
constexpr int LDSCTL_OFF = RING_BYTES, MISC_OFF = LDSCTL_OFF + 320;
constexpr int LDS_BYTES = 155648;

#define RFLF(x) __int_as_float(__builtin_amdgcn_readfirstlane(__float_as_int(x)))
#define GIN(k) ((const float*)(const GAS float*)F.in[k])
struct Frame {
    LAS unsigned char* lds;
    volatile LAS unsigned* MISC;
    gu32* ctl;
    int tid, lane, wave, wave0;
    int vcu, G;
    int rank, n, tok0;
    unsigned char* ar;
    const float* const __attribute__((address_space(4)))* in;
    float* out; unsigned char* ws;
};
#define DPPI(x, ctrl, rm) __builtin_amdgcn_update_dpp(0, (x), ctrl, rm, 0xF, false)
#define DPPF(x, ctrl, rm) __int_as_float(__builtin_amdgcn_update_dpp(0, __float_as_int(x), ctrl, rm, 0xF, false))
__device__ __forceinline__ float wave_sum_u(float v) {
    v += DPPF(v, 0xB1, 0xF); v += DPPF(v, 0x4E, 0xF); v += DPPF(v, 0x141, 0xF); v += DPPF(v, 0x140, 0xF);
    v += DPPF(v, 0x142, 0xA); v += DPPF(v, 0x143, 0xC);
    return __int_as_float(__builtin_amdgcn_readlane(__float_as_int(v), 63));
}
__device__ __forceinline__ int wave_sum_iu(int v) {
    v += DPPI(v, 0xB1, 0xF); v += DPPI(v, 0x4E, 0xF); v += DPPI(v, 0x141, 0xF); v += DPPI(v, 0x140, 0xF);
    v += DPPI(v, 0x142, 0xA); v += DPPI(v, 0x143, 0xC);
    return __builtin_amdgcn_readlane(v, 63);
}
__device__ __forceinline__ float wave_sum(float v) { return wave_sum_u(v); }
__device__ __forceinline__ int wave_sum_i(int v) { return wave_sum_iu(v); }
__device__ __forceinline__ void relaunder(Frame& F) {
    unsigned ones = ~0u; asm volatile("" : "+s"(ones));
    int t = F.wave0 * 64 + (int)__builtin_amdgcn_mbcnt_hi(ones, __builtin_amdgcn_mbcnt_lo(ones, 0u)); asm volatile("" : "+v"(t)); F.tid = t; F.lane = t & 63; F.wave = __builtin_amdgcn_readfirstlane(t >> 6);
    GAS unsigned char* w = (GAS unsigned char*)F.ws; asm volatile("" : "+s"(w)); F.ws = (unsigned char*)w;
    GAS unsigned char* a = (GAS unsigned char*)F.ar; asm volatile("" : "+s"(a)); F.ar = (unsigned char*)a;
    int rk_ = F.rank, nn_ = F.n; asm volatile("" : "+s"(rk_), "+s"(nn_)); F.rank = rk_; F.n = nn_;
    const float* const __attribute__((address_space(4)))* p = (const float* const __attribute__((address_space(4)))*)__builtin_amdgcn_kernarg_segment_ptr(); asm volatile("" : "+s"(p)); F.in = p;
}
__device__ __forceinline__ void transpose_item(const float* W, int K, int N, bf16* WT, int dst_row, LAS float* scr, int k0, int n0, int lane) {
    f32x4 tv[8];
#pragma unroll
    for (int i = 0; i < 8; ++i) tv[i] = *(const f32x4*)(W + (size_t)(k0 + 8 * i + (lane >> 3)) * N + n0 + (lane & 7) * 4);
#pragma unroll
    for (int i = 0; i < 8; ++i) { LAS float* d_ = scr + (8 * i + (lane >> 3)) * 33 + (lane & 7) * 4; d_[0] = tv[i][0]; d_[1] = tv[i][1]; d_[2] = tv[i][2]; d_[3] = tv[i][3]; }
    LDS_WAIT(); asm volatile("" ::: "memory");
    const int c = lane & 7;
#pragma unroll
    for (int j = 0; j < 4; ++j) { const int n = (lane >> 3) + 8 * j; const LAS float* s = scr + (8 * c) * 33 + n;
        v4u o; o.x = pk2(s[0 * 33], s[1 * 33]); o.y = pk2(s[2 * 33], s[3 * 33]); o.z = pk2(s[4 * 33], s[5 * 33]); o.w = pk2(s[6 * 33], s[7 * 33]);
        *(GAS v4u*)(WT + (size_t)(dst_row + n) * K + k0 + 8 * c) = o; }
    LDS_WAIT(); asm volatile("" ::: "memory");
}
__device__ __forceinline__ void transpose_item8(const float* W, int K, int N, unsigned char* WT, int dst_row, LAS float* scr, int k0, int n0, int lane, float sc) {
    f32x4 tv[8];
#pragma unroll
    for (int i = 0; i < 8; ++i) tv[i] = *(const f32x4*)(W + (size_t)(k0 + 8 * i + (lane >> 3)) * N + n0 + (lane & 7) * 4);
#pragma unroll
    for (int i = 0; i < 8; ++i) { LAS float* d_ = scr + (8 * i + (lane >> 3)) * 33 + (lane & 7) * 4; d_[0] = tv[i][0]; d_[1] = tv[i][1]; d_[2] = tv[i][2]; d_[3] = tv[i][3]; }
    LDS_WAIT(); asm volatile("" ::: "memory");
    const int q = lane & 3;
#pragma unroll
    for (int h = 0; h < 2; ++h) { const int n = (lane >> 2) + 16 * h; const LAS float* s = scr + (16 * q) * 33 + n; v4u o;
#pragma unroll
        for (int p = 0; p < 4; ++p) { unsigned w = 0;
            w = __builtin_amdgcn_cvt_pk_fp8_f32(s[(4 * p + 0) * 33] * sc, s[(4 * p + 1) * 33] * sc, w, false);
            w = __builtin_amdgcn_cvt_pk_fp8_f32(s[(4 * p + 2) * 33] * sc, s[(4 * p + 3) * 33] * sc, w, true);
            o[p] = w; }
        *(GAS v4u*)(WT + (size_t)(dst_row + n) * K + k0 + 16 * q) = o; }
    LDS_WAIT(); asm volatile("" ::: "memory");
}
template <int MODE>
__device__ __forceinline__ void prep_matrix(Frame& F, const float* W, int K, int N, bf16* WT, int row_off, LAS float* scr, int& ibase, int NC = 0) {
    const int nblk = (NC ? NC : N) / 32, nitems = (K / 64) * nblk;
    const int gw = F.vcu * NWAVES + F.wave, NGW = F.G * NWAVES;
    const int first = (gw - (ibase % NGW) + NGW) % NGW;
    for (int it = first; it < nitems; it += NGW) { const int kb = it / nblk, nb = it - kb * nblk, n0 = nb * 32;
        const int dst = (MODE & 1) ? row_off + (n0 >> 7) * 256 + (n0 & 127) : row_off + n0;
        if (MODE & 2) transpose_item8(W, K, N, (unsigned char*)WT, dst, scr, kb * 64, n0, F.lane, W8_SCALE);
        else transpose_item(W, K, N, WT, dst, scr, kb * 64, n0, F.lane); }
    ibase += nitems;
}
__device__ __forceinline__ void prep_matrix8p(Frame& F, const float* W, int K, int N, unsigned char* WT, int pitch, LAS float* scr, int& ibase) {
    const int nblk = N / 32, nitems = (K / 64) * nblk;
    const int gw = F.vcu * NWAVES + F.wave, NGW = F.G * NWAVES;
    const int first = (gw - (ibase % NGW) + NGW) % NGW;
    for (int it = first; it < nitems; it += NGW) { const int kb = it / nblk, nb = it - kb * nblk, n0 = nb * 32;
        transpose_item8(W, pitch, N, WT, n0, scr, kb * 64, n0, F.lane, W8_SCALE); }
    ibase += nitems;
}
__device__ __forceinline__ void p0_weights(Frame& F) {
    LAS float* scr = (LAS float*)(F.lds + RING_OFF + F.wave * 16384);
    int ib = 0;
    for (int l = 0; l < DEPTH; ++l) {
        unsigned char* wl = F.ws + WS_WL + (size_t)l * WL_STRIDE;
#if FP8_INPROJ_GATES
        prep_matrix<0>(F, GIN(4) + (size_t)l * DM * INC, DM, INC, (bf16*)(wl + WL_WIN), 0, scr, ib, ZGA);
        prep_matrix<2>(F, GIN(4) + (size_t)l * DM * INC + ZGA, DM, INC, (bf16*)(wl + WL_WIN + WL_WING8), 0, scr, ib, INC - ZGA);
#elif FP8_INPROJ_QKV
        prep_matrix<2>(F, GIN(4) + (size_t)l * DM * INC, DM, INC, (bf16*)(wl + WL_WIN), 0, scr, ib, ZGA);
        prep_matrix<0>(F, GIN(4) + (size_t)l * DM * INC + ZGA, DM, INC, (bf16*)(wl + WL_WIN + WL_WING), 0, scr, ib, INC - ZGA);
#else
        prep_matrix<0>(F, GIN(4) + (size_t)l * DM * INC, DM, INC, (bf16*)(wl + WL_WIN), 0, scr, ib);
#endif
        prep_matrix<0>(F, GIN(11) + (size_t)l * 1024 * DM, 1024, DM, (bf16*)(wl + WL_WPAD), 0, scr, ib);
        prep_matrix<0>(F, GIN(12) + (size_t)l * 1024 * DM, 1024, DM, (bf16*)(wl + WL_WPAD), 2048, scr, ib);
        prep_matrix<0>(F, GIN(13) + (size_t)l * DM * DM, DM, DM, (bf16*)(wl + WL_WO), 0, scr, ib);
    }
    for (int i = 0; i < 2; ++i) {
        unsigned char* wd = F.ws + WS_WD + (size_t)i * WD_STRIDE;
        prep_matrix<FP8_DENSE_UP ? 3 : 1>(F, GIN(18) + (size_t)i * DM * DFF, DM, DFF, (bf16*)(wd + WD_W13), 0, scr, ib);
        prep_matrix<FP8_DENSE_UP ? 3 : 1>(F, GIN(19) + (size_t)i * DM * DFF, DM, DFF, (bf16*)(wd + WD_W13), 128, scr, ib);
#if FP8_DENSE_DOWN
        prep_matrix8p(F, GIN(20) + (size_t)i * DFF * DM, DFF, DM, wd + WD_W2, DFF8, scr, ib);
#else
        prep_matrix<0>(F, GIN(20) + (size_t)i * DFF * DM, DFF, DM, (bf16*)(wd + WD_W2), 0, scr, ib);
#endif
        unsigned char* wm = F.ws + WS_WM + (size_t)i * WM_STRIDE;
        for (int e = 0; e < NEXP; ++e) {
            prep_matrix<FP8_MOE_UP ? 3 : 1>(F, GIN(22) + ((size_t)i * NEXP + e) * DM * DFE, DM, DFE, (bf16*)(wm + WM_W13), e * 2048, scr, ib);
            prep_matrix<FP8_MOE_UP ? 3 : 1>(F, GIN(23) + ((size_t)i * NEXP + e) * DM * DFE, DM, DFE, (bf16*)(wm + WM_W13), e * 2048 + 128, scr, ib);
            prep_matrix<FP8_MOE_DOWN ? 2 : 0>(F, GIN(24) + ((size_t)i * NEXP + e) * DFE * DM, DFE, DM, (bf16*)(wm + WM_W2), e * 2048, scr, ib);
        }
    }
#if FP8_DENSE_DOWN
    {
        const int gt = (F.vcu * NWAVES + F.wave) * 64 + F.lane, NGT = F.G * NWAVES * 64; const v4u z = {0u, 0u, 0u, 0u};
        constexpr int NU = MAXGRP * SROWS;
        for (int idx = gt; idx < (NU + 2 * DM) * 8; idx += NGT) { const int r = idx >> 3, c = idx & 7;
            unsigned char* rowp = r < NU ? F.ws + WS_ARENA + (size_t)(r / SROWS) * ARENA + A_U8 + (size_t)(r % SROWS) * DFF8 : F.ws + WS_WD + (size_t)((r - NU) / DM) * WD_STRIDE + WD_W2 + (size_t)((r - NU) % DM) * DFF8;
            *(GAS v4u*)(rowp + DFF + 16 * c) = z; }
    }
#endif
}
typedef float f32x2_ __attribute__((ext_vector_type(2)));
__device__ __forceinline__ void unpack8(f32x4& a, f32x4& b, v4u w) { a[0] = pg8::bf_lo(w.x); a[1] = pg8::bf_hi(w.x); a[2] = pg8::bf_lo(w.y); a[3] = pg8::bf_hi(w.y); b[0] = pg8::bf_lo(w.z); b[1] = pg8::bf_hi(w.z); b[2] = pg8::bf_lo(w.w); b[3] = pg8::bf_hi(w.w); }
template <bool ROUTE>
__device__ __forceinline__ void ln_row(Frame& F, f32x4 (&v)[8], const LAS float* gl, const LAS float* bl, const LAS float* rt, float* dst, bf16* xb, unsigned char* xlo, unsigned char* xb8, bool last, int row, int (&cnt)[8]) {
    float s = 0.f;
#pragma unroll
    for (int j = 0; j < 8; ++j) s += (v[j][0] + v[j][1]) + (v[j][2] + v[j][3]);
    const float mean = wave_sum_u(s) * (1.f / DM); float s2 = 0.f;
#pragma unroll
    for (int j = 0; j < 8; ++j) { v[j] = v[j] - mean; s2 += (v[j][0] * v[j][0] + v[j][1] * v[j][1]) + (v[j][2] * v[j][2] + v[j][3] * v[j][3]); }
    const float rstd = 1.f / sqrtf(wave_sum_u(s2) * (1.f / DM) + LN_EPS);
#pragma unroll
    for (int j = 0; j < 8; ++j) { const f32x4 g = *(const LAS f32x4*)(gl + (j * 64 + F.lane) * 4), b = *(const LAS f32x4*)(bl + (j * 64 + F.lane) * 4); v[j] = v[j] * rstd * g + b; }
    if (last) {
        LAS float* slab = (LAS float*)(F.lds + F.wave * 8192);
#pragma unroll
        for (int j = 0; j < 4; ++j) { *(LAS f32x4*)(slab + 8 * F.lane + 512 * j) = v[2 * j]; *(LAS f32x4*)(slab + 8 * F.lane + 512 * j + 4) = v[2 * j + 1]; }
#pragma unroll
        for (int q = 0; q < 8; ++q) *(f32x4*)(dst + 4 * F.lane + 256 * q) = *(const LAS f32x4*)(slab + 4 * F.lane + 256 * q);
    } else {
#pragma unroll
        for (int j = 0; j < 4; ++j) { v4u w, wl; const f32x4 a = v[2 * j], b = v[2 * j + 1];
            w.x = pg8::cvt_pk_bf16(a[0], a[1]); w.y = pg8::cvt_pk_bf16(a[2], a[3]); w.z = pg8::cvt_pk_bf16(b[0], b[1]); w.w = pg8::cvt_pk_bf16(b[2], b[3]);
            unsigned t0 = 0, t1 = 0;
            t0 = __builtin_amdgcn_cvt_pk_fp8_f32((a[0] - pg8::bf_lo(w.x)) * LO8_SCALE, (a[1] - pg8::bf_hi(w.x)) * LO8_SCALE, t0, false); t0 = __builtin_amdgcn_cvt_pk_fp8_f32((a[2] - pg8::bf_lo(w.y)) * LO8_SCALE, (a[3] - pg8::bf_hi(w.y)) * LO8_SCALE, t0, true);
            t1 = __builtin_amdgcn_cvt_pk_fp8_f32((b[0] - pg8::bf_lo(w.z)) * LO8_SCALE, (b[1] - pg8::bf_hi(w.z)) * LO8_SCALE, t1, false); t1 = __builtin_amdgcn_cvt_pk_fp8_f32((b[2] - pg8::bf_lo(w.w)) * LO8_SCALE, (b[3] - pg8::bf_hi(w.w)) * LO8_SCALE, t1, true);
            uint2 wl8; wl8.x = t0; wl8.y = t1; (void)wl;
            *(v4u*)(xb + 8 * F.lane + 512 * j) = w; *(uint2*)((unsigned char*)xlo + 8 * F.lane + 512 * j) = wl8; } }
    if (xb8) {
#pragma unroll
        for (int j = 0; j < 4; ++j) { uint2 w8; const f32x4 a = v[2 * j], b = v[2 * j + 1]; unsigned t = 0;
            t = __builtin_amdgcn_cvt_pk_fp8_f32(a[0], a[1], t, false); t = __builtin_amdgcn_cvt_pk_fp8_f32(a[2], a[3], t, true); w8.x = t;
            t = __builtin_amdgcn_cvt_pk_fp8_f32(b[0], b[1], t, false); t = __builtin_amdgcn_cvt_pk_fp8_f32(b[2], b[3], t, true); w8.y = t;
            *(uint2*)(xb8 + 8 * F.lane + 512 * j) = w8; } }
    if (ROUTE) {
        float lg[8];
#pragma unroll
        for (int e = 0; e < 8; ++e) { float a = 0.f;
#pragma unroll
            for (int j = 0; j < 8; ++j) { const f32x4 w = *(const LAS f32x4*)(rt + e * DM + (j * 64 + F.lane) * 4); a += (v[j][0] * w[0] + v[j][1] * w[1]) + (v[j][2] * w[2] + v[j][3] * w[3]); }
            lg[e] = wave_sum_u(a); }
        float v1 = -INFINITY; int e1 = 0;
#pragma unroll
        for (int e = 0; e < 8; ++e) if (lg[e] > v1) { v1 = lg[e]; e1 = e; }
        float v2 = -INFINITY; int e2 = 0;
#pragma unroll
        for (int e = 0; e < 8; ++e) if (e != e1 && lg[e] > v2) { v2 = lg[e]; e2 = e; }
        const float g1 = 1.f / (1.f + expf(v2 - v1)), g2 = 1.f - g1;
#pragma unroll
        for (int e = 0; e < 8; ++e) cnt[e] += (e == e1) + (e == e2);
        if (F.lane == 0) { int4 r; r.x = e1; r.y = e2; r.z = __float_as_int(g1); r.w = __float_as_int(g2); *(int4*)(F.ar + A_ROUTE + (size_t)row * 16) = r; }
    }
}
__device__ __forceinline__ void grp_wait(const XcdBarrier& b, unsigned genw, volatile LAS unsigned* slot);
template <int MODE, bool ROUTE>
__device__ __forceinline__ void ln_phase(Frame& F, const float* gsrc, const float* bsrc, const float* router, bool last, bool want8 = false, const XcdBarrier* pb = nullptr, unsigned genw = 0) {
    LAS float* rt = (LAS float*)(F.lds);
    LAS int* wcnt = (LAS int*)(F.lds + 65536);
    LAS float* gl = (LAS float*)(F.lds + 69632); LAS float* bl = gl + DM;
#define LNPOS(d) (((2 * ((d) >> 9) + (((d) >> 2) & 1)) * 64 + (((d) >> 3) & 63)) * 4 + ((d) & 3))
    for (int idx = F.tid; idx < DM; idx += NWAVES * 64) { gl[LNPOS(idx)] = gsrc[idx]; bl[LNPOS(idx)] = bsrc[idx]; }
    if (ROUTE) { float rv[32];
#pragma unroll
        for (int q = 0; q < 32; ++q) rv[q] = router[F.tid + q * (NWAVES * 64)];
#pragma unroll
        for (int q = 0; q < 32; ++q) { const int idx = F.tid + q * (NWAVES * 64), d = idx >> 3; rt[(idx & 7) * DM + LNPOS(d)] = rv[q]; } }
#undef LNPOS
    if (pb) grp_wait(*pb, genw, F.MISC + 15); else __syncthreads();
    bf16* XB = (bf16*)(F.ar + A_XB); unsigned char* XLO = F.ar + A_XLO; unsigned char* XB8 = F.ar + A_XB8;
    const bf16* MIX = (const bf16*)(F.ar + A_MIX);
    const bf16* OM = (const bf16*)(F.ar + A_OM);
#define LD16(p, j) (*(const v4u*)((p) + 8 * F.lane + 512 * (j)))
#define LD8B(p, j) (*(const uint2*)((p) + 8 * F.lane + 512 * (j)))
#define UNLO(a, b, w) do { const f32x2_ q0 = __builtin_amdgcn_cvt_pk_f32_fp8((int)(w).x, false), q1 = __builtin_amdgcn_cvt_pk_f32_fp8((int)(w).x, true), q2 = __builtin_amdgcn_cvt_pk_f32_fp8((int)(w).y, false), q3 = __builtin_amdgcn_cvt_pk_f32_fp8((int)(w).y, true); \
    a[0] = q0.x * (1.f / LO8_SCALE); a[1] = q0.y * (1.f / LO8_SCALE); a[2] = q1.x * (1.f / LO8_SCALE); a[3] = q1.y * (1.f / LO8_SCALE); b[0] = q2.x * (1.f / LO8_SCALE); b[1] = q2.y * (1.f / LO8_SCALE); b[2] = q3.x * (1.f / LO8_SCALE); b[3] = q3.y * (1.f / LO8_SCALE); } while (0)
    for (int seg = F.rank; seg < SEGS; seg += F.n) {
        int cnt[8];
#pragma unroll
        for (int e = 0; e < 8; ++e) cnt[e] = 0;
        v4u ha[4], hb[4], wa[4], wb[4], wa2[4], wb2[4]; uint2 la[4], lb[4]; f32x4 ra[8], rb[8]; int4 ts = {0, 0, 0, 0}, tsn = {0, 0, 0, 0};
#define LN_LOADA(i, tsv) do { const int rA_ = SEGROW(seg, F.wave, (i)); \
            if (MODE == 0) { const size_t gA_ = (size_t)F.tok0 + rA_; const float* srcA = gA_ < (size_t)TPROMPT ? GIN(0) + gA_ * DM : GIN(1) + (gA_ - TPROMPT) * DM; \
                _Pragma("unroll") for (int q = 0; q < 8; ++q) ra[q] = *(const f32x4*)(srcA + 4 * F.lane + 256 * q);     \
            } else { const bf16* hA = XB + (size_t)rA_ * DM; const unsigned char* lA = XLO + (size_t)rA_ * DM; \
                if (MODE == 1 || MODE == 2) { const bf16* mA = MIX + (size_t)rA_ * DM; \
                    _Pragma("unroll") for (int j = 0; j < 4; ++j) { ha[j] = LD16(hA, j); la[j] = LD8B(lA, j); wa[j] = LD16(mA, j); } \
                } else { const bf16* a1 = OM + (size_t)(tsv).x * DM; const bf16* a2 = OM + (size_t)(tsv).y * DM; \
                    _Pragma("unroll") for (int j = 0; j < 4; ++j) { ha[j] = LD16(hA, j); la[j] = LD8B(lA, j); wa[j] = LD16(a1, j); wa2[j] = LD16(a2, j); } } } \
            __builtin_amdgcn_sched_barrier(0); } while (0)
#define LN_LOADB(i, tsv) do { const int rB_ = SEGROW(seg, F.wave, (i)) + 1; \
            if (MODE == 0) { const size_t gB_ = (size_t)F.tok0 + rB_; const float* srcB = gB_ < (size_t)TPROMPT ? GIN(0) + gB_ * DM : GIN(1) + (gB_ - TPROMPT) * DM; \
                _Pragma("unroll") for (int q = 0; q < 8; ++q) rb[q] = *(const f32x4*)(srcB + 4 * F.lane + 256 * q); \
            } else { const bf16* hB = XB + (size_t)rB_ * DM; const unsigned char* lB = XLO + (size_t)rB_ * DM; \
                if (MODE == 1 || MODE == 2) { const bf16* mB = MIX + (size_t)rB_ * DM; \
                    _Pragma("unroll") for (int j = 0; j < 4; ++j) { hb[j] = LD16(hB, j); lb[j] = LD8B(lB, j); wb[j] = LD16(mB, j); } \
                } else { const bf16* b1 = OM + (size_t)(tsv).z * DM; const bf16* b2 = OM + (size_t)(tsv).w * DM; \
                    _Pragma("unroll") for (int j = 0; j < 4; ++j) { hb[j] = LD16(hB, j); lb[j] = LD8B(lB, j); wb[j] = LD16(b1, j); wb2[j] = LD16(b2, j); } } } \
            __builtin_amdgcn_sched_barrier(0); } while (0)
        if (MODE == 3) ts = *(const int4*)(F.ar + A_TOKSLOT + (size_t)SEGROW(seg, F.wave, 0) * 8);
        LN_LOADA(0, ts); LN_LOADB(0, ts);
        for (int i = 0; i < 8; i += 2) {
            const int rowA = SEGROW(seg, F.wave, i), rowB = rowA + 1; const size_t growA = (size_t)F.tok0 + rowA, growB = growA + 1;
            if (MODE == 3 && i + 2 < 8) { tsn = *(const int4*)(F.ar + A_TOKSLOT + (size_t)SEGROW(seg, F.wave, i + 2) * 8); __builtin_amdgcn_sched_barrier(0); }
            f32x4 va[8], vb[8];
            if (MODE == 0) {
                LAS float* slab = (LAS float*)(F.lds + F.wave * 8192);
#pragma unroll
                for (int q = 0; q < 8; ++q) *(LAS f32x4*)(slab + 4 * F.lane + 256 * q) = ra[q];
#pragma unroll
                for (int j = 0; j < 4; ++j) { va[2 * j] = *(const LAS f32x4*)(slab + 8 * F.lane + 512 * j); va[2 * j + 1] = *(const LAS f32x4*)(slab + 8 * F.lane + 512 * j + 4); }
#pragma unroll
                for (int q = 0; q < 8; ++q) *(LAS f32x4*)(slab + 4 * F.lane + 256 * q) = rb[q];
#pragma unroll
                for (int j = 0; j < 4; ++j) { vb[2 * j] = *(const LAS f32x4*)(slab + 8 * F.lane + 512 * j); vb[2 * j + 1] = *(const LAS f32x4*)(slab + 8 * F.lane + 512 * j + 4); }
            } else if (MODE == 1 || MODE == 2) {
#pragma unroll
                for (int j = 0; j < 4; ++j) { f32x4 h0, h1, l0, l1, m0, m1;
                    unpack8(h0, h1, ha[j]); UNLO(l0, l1, la[j]); unpack8(m0, m1, wa[j]); va[2 * j] = (h0 + l0) * ALPHA + m0; va[2 * j + 1] = (h1 + l1) * ALPHA + m1;
                    unpack8(h0, h1, hb[j]); UNLO(l0, l1, lb[j]); unpack8(m0, m1, wb[j]); vb[2 * j] = (h0 + l0) * ALPHA + m0; vb[2 * j + 1] = (h1 + l1) * ALPHA + m1; }
            } else {
#pragma unroll
                for (int j = 0; j < 4; ++j) { f32x4 h0, h1, l0, l1, m0, m1, n0, n1;
                    unpack8(h0, h1, ha[j]); UNLO(l0, l1, la[j]); unpack8(m0, m1, wa[j]); unpack8(n0, n1, wa2[j]); va[2 * j] = (h0 + l0) * ALPHA + (m0 + n0); va[2 * j + 1] = (h1 + l1) * ALPHA + (m1 + n1);
                    unpack8(h0, h1, hb[j]); UNLO(l0, l1, lb[j]); unpack8(m0, m1, wb[j]); unpack8(n0, n1, wb2[j]); vb[2 * j] = (h0 + l0) * ALPHA + (m0 + n0); vb[2 * j + 1] = (h1 + l1) * ALPHA + (m1 + n1); }
            }
            __builtin_amdgcn_sched_barrier(0);
            if (i + 2 < 8) LN_LOADA(i + 2, tsn);
            ln_row<ROUTE>(F, va, gl, bl, rt, F.out + growA * DM, XB + (size_t)rowA * DM, XLO + (size_t)rowA * DM, want8 ? XB8 + (size_t)rowA * DM : nullptr, last, rowA, cnt);
            __builtin_amdgcn_sched_barrier(0);
            if (i + 2 < 8) LN_LOADB(i + 2, tsn);
            ln_row<ROUTE>(F, vb, gl, bl, rt, F.out + growB * DM, XB + (size_t)rowB * DM, XLO + (size_t)rowB * DM, want8 ? XB8 + (size_t)rowB * DM : nullptr, last, rowB, cnt);
        }
#undef LN_LOADA
#undef LN_LOADB
        if (ROUTE) {
            if (F.lane == 0) {
#pragma unroll
                for (int e = 0; e < 8; ++e) wcnt[F.wave * 8 + e] = cnt[e]; }
            __syncthreads();
            if (F.tid < 8) { int t = 0;
#pragma unroll
                for (int w = 0; w < 8; ++w) t += wcnt[w * 8 + F.tid];
                *(int*)(F.ar + A_SEGCNT + ((size_t)seg * 8 + F.tid) * 4) = t; }
            __syncthreads();
        }
    }
#undef LD16
#undef LD8B
#undef UNLO
    __syncthreads();
}
__device__ __forceinline__ void moe_assign_phase(Frame& F) {
    LAS int* sc = (LAS int*)(F.lds);
    LAS int* tot = sc + SEGS * 8; LAS int* pre = tot + 8; LAS int* off = pre + 8; LAS int* e1s = off + 16; LAS int* e2s = e1s + 64; LAS int* sl1 = e2s + 64; LAS int* sl2 = sl1 + 64;
    const bf16* XB = (const bf16*)(F.ar + A_XB); bf16* HBG = (bf16*)(F.ar + A_HBG);
    for (int seg = F.rank; seg < SEGS; seg += F.n) {
        for (int idx = F.tid; idx < SEGS * 8; idx += NWAVES * 64) sc[idx] = *(const int*)(F.ar + A_SEGCNT + (size_t)idx * 4);
        int4 r = {0, 0, 0, 0};
        if (F.tid < 64) { r = *(const int4*)(F.ar + A_ROUTE + (size_t)SEGROW(seg, F.tid >> 3, F.tid & 7) * 16); e1s[F.tid] = r.x; e2s[F.tid] = r.y; }
        __syncthreads();
        { const int e = F.wave; int t = 0, p = 0;
          if (F.lane < SEGS) { const int s2 = F.lane; const int c = sc[s2 * 8 + e]; t = c; p = (s2 < seg) ? c : 0; }
          t = wave_sum_i(t); p = wave_sum_i(p); if (F.lane == 0) { tot[e] = t; pre[e] = p; } }
        __syncthreads();
        if (F.tid == 0) { int o = 0;
            for (int e = 0; e < 8; ++e) { off[e] = o; o += (tot[e] + 255) & ~255; }
            off[8] = o;
            if (seg == 0) { for (int e = 0; e <= 8; ++e) *(int*)(F.ar + A_MOEOFF + e * 4) = off[e]; } }
        __syncthreads();
        if (F.tid < 64) { const int e1 = r.x, e2 = r.y; int r1 = 0, r2 = 0;
            for (int t2 = 0; t2 < F.tid; ++t2) { const int a = e1s[t2], b = e2s[t2]; r1 += (a == e1) + (b == e1); r2 += (a == e2) + (b == e2); }
            const int s1 = off[e1] + pre[e1] + r1, s2 = off[e2] + pre[e2] + r2;
            int2 ts; ts.x = s1; ts.y = s2; *(int2*)(F.ar + A_TOKSLOT + (size_t)SEGROW(seg, F.tid >> 3, F.tid & 7) * 8) = ts;
            *(int*)(F.ar + A_SLOTGATE + (size_t)s1 * 4) = r.z; *(int*)(F.ar + A_SLOTGATE + (size_t)s2 * 4) = r.w;
            sl1[F.tid] = s1; sl2[F.tid] = s2; }
        __syncthreads();
#pragma unroll 8
        for (int q = F.wave * 16; q < F.wave * 16 + 16; ++q) { const int tok = q >> 1; const int slot = (q & 1) ? sl2[tok] : sl1[tok];
#if FP8_MOE_UP
            const v4u* src = (const v4u*)(F.ar + A_XB8 + (size_t)SEGROW(seg, tok >> 3, tok & 7) * DM); v4u* dst = (v4u*)((unsigned char*)HBG + (size_t)slot * DM);
            const v4u t0 = src[F.lane], t1 = src[F.lane + 64]; dst[F.lane] = t0; dst[F.lane + 64] = t1; }
#else
            const v4u* src = (const v4u*)(XB + (size_t)SEGROW(seg, tok >> 3, tok & 7) * DM); v4u* dst = (v4u*)(HBG + (size_t)slot * DM);
#pragma unroll
            for (int i = 0; i < 4; ++i) dst[F.lane + 64 * i] = src[F.lane + 64 * i]; }
#endif
        __syncthreads();
    }
}
__device__ __forceinline__ void attn_phase(Frame& F, int l, char* lds) {
    asm volatile("" : "+s"(l));
    const att::bf16* Z = (const att::bf16*)(F.ar + A_Z);
    att::bf16* YA = (att::bf16*)(F.ar + A_YAD); att::bf16* YD = YA + (size_t)SROWS * 1024;
    const float* lq1 = GIN(6) + l * 128; const float* lk1 = GIN(7) + l * 128; const float* lq2 = GIN(8) + l * 128; const float* lk2 = GIN(9) + l * 128;
    const float d1 = wave_sum(lq1[F.lane] * lk1[F.lane] + lq1[F.lane + 64] * lk1[F.lane + 64]);
    const float d2 = wave_sum(lq2[F.lane] * lk2[F.lane] + lq2[F.lane + 64] * lk2[F.lane + 64]);
    const float linit = RFLF(l == 0 ? 0.2f : l == 1 ? 0.35550906759096926f : l == 2 ? 0.4707130183435842f : 0.5560582041556405f);
    const float lam = __int_as_float(__builtin_amdgcn_readfirstlane(__float_as_int(expf(d1) - expf(d2) + linit)));
    float* Scr = (float*)(F.ws + WS_SCR) + (size_t)blockIdx.x * (256 * 256);
#ifndef ATT_DIFF_REPS
#define ATT_DIFF_REPS 1
#endif
#ifndef ATT_WIN_REPS
#define ATT_WIN_REPS 1
#endif
    int rk = F.rank; asm volatile("" : "+s"(rk));
    for (int u = rk; u < 4 * 8; u += F.n) {
        const int qb = u & 7, h = u >> 3;
        const size_t row0 = 0;
        const att::bf16* V = Z + row0 * INC + ZVD + h * 256;
        const float slope = exp2f(-8.0f * (float)(9 + h) / 12.0f);
        att::attn_diff_body<false>(Z + (row0 + qb * 256) * INC + ZQD + (h * 2 + 0) * 128, Z + row0 * INC + ZKD + (h * 2 + 0) * 128, V, Scr, nullptr, 0, lds, qb * 256, RFLF(-slope * att::LOG2E), 0.f, 0.f, nullptr, SEQ, F.wave0);
        att::attn_diff_body<true>(Z + (row0 + qb * 256) * INC + ZQD + (h * 2 + 1) * 128, Z + row0 * INC + ZKD + (h * 2 + 1) * 128, V, Scr, YD + (row0 + qb * 256) * 1024 + h * 256, 1024, lds, qb * 256, RFLF(-slope * att::LOG2E), lam, RFLF(1.f - linit), GIN(10) + l * 256, SEQ, F.wave0);
    }
    for (int u = rk; u < 8 * 8; u += F.n) {
        const int qb = u & 7, hq = u >> 3, g = hq >> 2;
        const size_t row0 = 0;
        const int klo = qb * 256 - 128 < 0 ? 0 : qb * 256 - 128, khi = qb * 256 + 384 > SEQ ? SEQ : qb * 256 + 384;
        const att::bf16* Q = Z + (row0 + qb * 256) * INC + ZQA + hq * 128;
        const att::bf16* K = Z + (row0 + klo) * INC + ZKA + g * 128;
        const att::bf16* V = Z + (row0 + klo) * INC + ZVA + g * 128;
        att::bf16* O = YA + (row0 + qb * 256) * 1024 + hq * 128;
        const float slope = exp2f(-8.0f * (float)(1 + hq) / 12.0f);
        const float sink = GIN(5)[l * 8 + hq];
        att::attn_win_body(Q, K, V, O, 1024, lds, qb * 256 - klo, RFLF(-slope * att::LOG2E), RFLF(sink * att::LOG2E), khi - klo, F.wave0);
    }
}

#define GB_SUB(j) (XCD_BAR_WORDS + 64 * (j))
#define GB_GEN(j) (XCD_BAR_WORDS + 1024 + 64 * (j))
#define TB_SUB(j, t) (XCD_BAR_WORDS + 2048 + ((j) * 8 + (t)) * 64)
#define TB_GEN(j, t) (XCD_BAR_WORDS + 2048 + 8192 + ((j) * 8 + (t)) * 64)
__device__ __forceinline__ void bar_any(const XcdBarrier& b, unsigned subw, unsigned genw, bool team) {
    asm volatile("s_waitcnt vmcnt(0)" ::: "memory");
    __syncthreads();
    if (threadIdx.x == 0) {
        unsigned* bar = b.bar;
        __builtin_amdgcn_s_waitcnt(0);
        const unsigned old = xb_add(&bar[subw], 1u);
        const unsigned nloc = team ? 4u : b.st[0];
        const unsigned gen = team ? (old >> 2) : old / nloc;
        if (old + 1u == (gen + 1u) * nloc) xb_add(&bar[genw], 1u);
        else XB_SPIN(xb_ld(&bar[genw]) == gen, bar);
        __builtin_amdgcn_fence(__ATOMIC_ACQUIRE, "agent");
        asm volatile("s_waitcnt vmcnt(0)" ::: "memory");
    }
    __syncthreads();
}
__device__ __forceinline__ void arrive_any(const XcdBarrier& b, unsigned subw, unsigned genw, bool team, volatile LAS unsigned* slot) {
    asm volatile("s_waitcnt vmcnt(0)" ::: "memory");
    __syncthreads();
    if (threadIdx.x == 0) {
        unsigned* bar = b.bar;
        __builtin_amdgcn_s_waitcnt(0);
        const unsigned old = xb_add(&bar[subw], 1u);
        const unsigned nloc = team ? 4u : b.st[0];
        const unsigned gen = team ? (old >> 2) : old / nloc;
        if (old + 1u == (gen + 1u) * nloc) xb_add(&bar[genw], 1u);
        *slot = gen;
    }
}
__device__ __forceinline__ void grp_wait(const XcdBarrier& b, unsigned genw, volatile LAS unsigned* slot) {
    if (threadIdx.x == 0) {
        unsigned* bar = b.bar; const unsigned gen = *slot;
        XB_SPIN(xb_ld(&bar[genw]) == gen, bar);
        __builtin_amdgcn_fence(__ATOMIC_ACQUIRE, "agent");
        asm volatile("s_waitcnt vmcnt(0)" ::: "memory");
    }
    __syncthreads();
}

struct Args { const float* in[25]; float* out; unsigned char* ws; int pad0, pad1; };
__global__ void __launch_bounds__(NWAVES * 64, 2) mk_fwd(Args args) {
    extern __shared__ __attribute__((aligned(16))) unsigned char lds[];
    Frame F;
    F.lds = (LAS unsigned char*)lds;
    F.MISC = (volatile LAS unsigned*)(F.lds + MISC_OFF);
    F.tid = threadIdx.x; F.lane = F.tid & 63; F.wave = __builtin_amdgcn_readfirstlane(F.tid >> 6); F.wave0 = F.wave;
    F.G = gridDim.x; { const int bx = blockIdx.x; F.vcu = (F.G % 8 == 0) ? (bx % 8) * (F.G / 8) + bx / 8 : bx; }
    F.in = (const float* const __attribute__((address_space(4)))*)__builtin_amdgcn_kernarg_segment_ptr(); F.out = args.out; F.ws = args.ws; F.ar = args.ws;
    F.ctl = (gu32*)(args.ws + WS_CTL);
    for (int u = F.tid; u < (LDS_BYTES - LDSCTL_OFF) / 4; u += NWAVES * 64) ((LAS unsigned*)(F.lds + LDSCTL_OFF))[u] = 0u;
    __syncthreads();
    XcdBarrier bar; bar.bar = (unsigned*)(F.ctl + CW_BAR); bar.x = xb_xcc_id(); bar.st = F.MISC + 8;
    if (F.tid == 0) F.MISC[12] = xb_add(&bar.bar[XB_XCNT(bar.x)], 1u);
    typedef pg8::bf16_t pbf;

    relaunder(F); p0_weights(F);
    xcd_barrier(bar);
    if (F.tid == 0) { unsigned g = 0, ng = 0;
        for (unsigned j = 0; j < 16; ++j) { const unsigned c = xb_ld(&bar.bar[XB_XCNT(j)]); if (c) { ++ng; if (j < bar.x) ++g; } }
        F.MISC[13] = g; F.MISC[14] = ng; }
    __syncthreads();
    F.rank = (int)__builtin_amdgcn_readfirstlane((int)F.MISC[12]); F.n = (int)__builtin_amdgcn_readfirstlane((int)F.MISC[8]);
    const int grp = (int)__builtin_amdgcn_readfirstlane((int)F.MISC[13]); int ngrp = (int)__builtin_amdgcn_readfirstlane((int)F.MISC[14]);
    if (ngrp > MAXGRP) ngrp = MAXGRP;
    if (F.n < 1) F.n = 1;
    F.ar = args.ws + WS_ARENA + (size_t)(grp < MAXGRP ? grp : 0) * ARENA;
    const bool teams = F.n == 32;
    const unsigned g_sub = GB_SUB(bar.x), g_gen = GB_GEN(bar.x);
    const unsigned t_sub = teams ? TB_SUB(bar.x, F.rank & 7) : g_sub, t_gen = teams ? TB_GEN(bar.x, F.rank & 7) : g_gen;
#define SEAM() bar_any(bar, g_sub, g_gen, false)
#define TSEAM() bar_any(bar, t_sub, t_gen, teams)
#ifndef GRP_SKEW_TICKS
#define GRP_SKEW_TICKS 0
#endif
    if (GRP_SKEW_TICKS) { if (F.tid == 0) { const unsigned long long t0 = __builtin_amdgcn_s_memrealtime(), dt = (unsigned long long)GRP_SKEW_TICKS * (unsigned)grp;
            while (__builtin_amdgcn_s_memrealtime() - t0 < dt) __builtin_amdgcn_s_sleep(16); }
        __syncthreads(); }

    if (grp < MAXGRP)
    for (int sg = grp; sg < NSEQ_ALL; sg += ngrp)
    for (int l = 0; l < DEPTH; ++l) {
        F.tok0 = sg * SROWS;
        const bool moe = (l & 1) != 0; const int fi = l >> 1;
        if (l == 0) { relaunder(F); ln_phase<0, false>(F, GIN(2), GIN(3), nullptr, false, true); TSEAM(); }
        {
            relaunder(F); unsigned char* ws = F.ws; unsigned char* ar = F.ar; unsigned char* wl = ws + WS_WL + (size_t)l * WL_STRIDE;
            { pg8::Gemm g{(const pbf*)(ar + A_XB), (const pbf*)(wl + WL_WIN), SROWS, ZGA, DM}; pg8::StaticOrder S; S.init(SROWS, ZGA, F.n, F.rank);
              pg8::EpiPlain E{(pbf*)(ar + A_Z), INC, 0x7fffffff, 0x7fffffff, 0x3CFu, att::CS, 1.0f};
              pg8::gemm_phase<pg8::EpiPlain, pg8::StaticOrder, PG8_ALIGN, PG8_SP2>(F.lds + RING_OFF, g, S, E, F.tid); }
            { pg8::Gemm g{(const pbf*)(ar + A_XB8), (const pbf*)(wl + WL_WIN + WL_WING8), SROWS, INC - ZGA, DM / 2};
              pg8::UnevenOrder S; S.init(SROWS, INC - ZGA, F.n, F.rank, (SROWS / 256) * (ZGA / 256), 3, 5);
              pg8::EpiPlain E{(pbf*)(ar + A_Z) + ZGA, INC, 0x7fffffff, 0, 0u, 1.0f, 1.0f / W8_SCALE};
              pg8::gemm_phase<pg8::EpiPlain, pg8::UnevenOrder, PG8_ALIGN, PG8_SP2, true>(F.lds + RING_OFF, g, S, E, F.tid); }
            SEAM();
        }
        { relaunder(F); attn_phase(F, l, (char*)lds + RING_OFF); SEAM(); }
        {
            relaunder(F); unsigned char* ws = F.ws; unsigned char* ar = F.ar; unsigned char* wl = ws + WS_WL + (size_t)l * WL_STRIDE;
            pg8::Gemm g{(const pbf*)(ar + A_YAD), (const pbf*)(wl + WL_WPAD), 2 * SROWS, 4096, 1024}; pg8::PairOrder S; S.init(SROWS, F.n, F.rank);
            pg8::EpiGate E{(const pbf*)(ar + A_Z) + ZGA, INC, (pbf*)(ar + A_MERGED), DM, SROWS / 256};
            pg8::gemm_phase<pg8::EpiGate, pg8::PairOrder, PG8_ALIGN, PG8_SP2>(F.lds + RING_OFF, g, S, E, F.tid);
            TSEAM();
        }
        {
            relaunder(F); unsigned char* ws = F.ws; unsigned char* ar = F.ar; unsigned char* wl = ws + WS_WL + (size_t)l * WL_STRIDE;
            pg8::Gemm g{(const pbf*)(ar + A_MERGED), (const pbf*)(wl + WL_WO), SROWS, DM, DM}; pg8::StaticOrder S; S.init(SROWS, DM, F.n, F.rank);
            pg8::EpiPlain E{(pbf*)(ar + A_MIX), DM, 0x7fffffff, 0x7fffffff, 0u, 1.0f, 1.0f};
            pg8::gemm_phase<pg8::EpiPlain, pg8::StaticOrder, PG8_ALIGN, PG8_SP2>(F.lds + RING_OFF, g, S, E, F.tid);
            arrive_any(bar, t_sub, t_gen, teams, F.MISC + 15);
        }
        { relaunder(F); if (moe) ln_phase<1, true>(F, GIN(14) + l * DM, GIN(15) + l * DM, GIN(21) + (size_t)fi * DM * NEXP, false, true, &bar, t_gen); else ln_phase<2, false>(F, GIN(14) + l * DM, GIN(15) + l * DM, nullptr, false, true, &bar, t_gen); if (moe) SEAM(); else TSEAM(); }
        if (!moe) {
            {
                relaunder(F); unsigned char* ws = F.ws; unsigned char* ar = F.ar; unsigned char* wd = ws + WS_WD + (size_t)fi * WD_STRIDE;
                pg8::StaticOrder S; S.init(SROWS, 2 * DFF, F.n, F.rank);
                pg8::Gemm g{(const pbf*)(ar + A_XB8), (const pbf*)(wd + WD_W13), SROWS, 2 * DFF, DM / 2};
                pg8::EpiSwiGlu<true> E{(pbf*)(ar + A_U8), DFF8, 0x7fffffff, nullptr, 1.0f / W8_SCALE, U8_SCALE};
                pg8::gemm_phase<pg8::EpiSwiGlu<true>, pg8::StaticOrder, PG8_ALIGN, PG8_SP2, true>(F.lds + RING_OFF, g, S, E, F.tid);
                TSEAM();
            }
            {
                relaunder(F); unsigned char* ws = F.ws; unsigned char* ar = F.ar; unsigned char* wd = ws + WS_WD + (size_t)fi * WD_STRIDE;
                pg8::StaticOrder S; S.init(SROWS, DM, F.n, F.rank);
                pg8::Gemm g{(const pbf*)(ar + A_U8), (const pbf*)(wd + WD_W2), SROWS, DM, DFF8 / 2};
                pg8::EpiPlain E{(pbf*)(ar + A_MIX), DM, 0x7fffffff, 0x7fffffff, 0u, 1.0f, 1.0f / (W8_SCALE * U8_SCALE)};
                pg8::gemm_phase<pg8::EpiPlain, pg8::StaticOrder, PG8_ALIGN, PG8_SP2, true>(F.lds + RING_OFF, g, S, E, F.tid);
                arrive_any(bar, t_sub, t_gen, teams, F.MISC + 15);
            }
            { relaunder(F); ln_phase<2, false>(F, GIN(16) + l * DM, GIN(17) + l * DM, nullptr, l + 1 == DEPTH, true, &bar, t_gen); TSEAM(); }
        } else {
            { relaunder(F); moe_assign_phase(F); SEAM(); }
            {
                relaunder(F);
                const int* mo = (const int*)(F.ar + A_MOEOFF);
#define RFL(x) __builtin_amdgcn_readfirstlane(x)
                pg8::MoeOrder S; S.po1 = RFL(mo[1] >> 8); S.po2 = RFL(mo[2] >> 8); S.po3 = RFL(mo[3] >> 8); S.po4 = RFL(mo[4] >> 8); S.po5 = RFL(mo[5] >> 8); S.po6 = RFL(mo[6] >> 8); S.po7 = RFL(mo[7] >> 8); S.P = RFL(mo[8] >> 8);
#undef RFL
                S.G = F.n; S.c = F.rank;
                if (S.P > SLOTS_G / 256) S.P = SLOTS_G / 256;
                {
                    relaunder(F); unsigned char* ws = F.ws; unsigned char* ar = F.ar; unsigned char* wm = ws + WS_WM + (size_t)fi * WM_STRIDE;
                    pg8::Gemm g{(const pbf*)(ar + A_HBG), (const pbf*)(wm + WM_W13), SLOTS_G, NEXP * 2048, DM / 2};
                    pg8::EpiSwiGlu<true> E{(pbf*)(ar + A_UM), DFE, 7, (const float*)(ar + A_SLOTGATE), 1.0f / W8_SCALE, U8_SCALE};
                    pg8::gemm_phase<pg8::EpiSwiGlu<true>, pg8::MoeOrder, PG8_ALIGN, PG8_SP2, true>(F.lds + RING_OFF, g, S, E, F.tid);
                    SEAM();
                }
                {
                    relaunder(F); unsigned char* ws = F.ws; unsigned char* ar = F.ar; unsigned char* wm = ws + WS_WM + (size_t)fi * WM_STRIDE;
                    pg8::Gemm g{(const pbf*)(ar + A_UM), (const pbf*)(wm + WM_W2), SLOTS_G, NEXP * 2048, DFE / 2};
                    pg8::EpiPlain E{(pbf*)(ar + A_OM), DM, 7, 0x7fffffff, 0u, 1.0f, 1.0f / (W8_SCALE * U8_SCALE)};
                    pg8::gemm_phase<pg8::EpiPlain, pg8::MoeOrder, PG8_ALIGN, PG8_SP2, true>(F.lds + RING_OFF, g, S, E, F.tid);
                    arrive_any(bar, g_sub, g_gen, false, F.MISC + 15);
                }
            }
            { relaunder(F); ln_phase<3, false>(F, GIN(16) + l * DM, GIN(17) + l * DM, nullptr, l + 1 == DEPTH, true, &bar, g_gen); TSEAM(); }
        }
    }
#undef SEAM
}

extern "C" void kernel_launch(void* const* d_in, const int* in_sizes, int n_in, void* d_out, int out_size, void* d_ws, size_t ws_size, hipStream_t stream) {
    static int grid = 0;
    if (grid == 0) {
        if (n_in != 25 || in_sizes[0] != TPROMPT * DM || in_sizes[1] != (TTOT - TPROMPT) * DM || out_size != TTOT * DM || ws_size < WS_END) {
            fprintf(stderr, "kernel_launch: shape/workspace mismatch (n_in %d, ws %zu, need %zu); nothing launched\n", n_in, ws_size, (size_t)WS_END); grid = -1; return; }
        int dev = 0, cus = 0;
        if (hipGetDevice(&dev) != hipSuccess || hipDeviceGetAttribute(&cus, hipDeviceAttributeMultiprocessorCount, dev) != hipSuccess) { grid = -1; return; }
        if (hipFuncSetAttribute((const void*)mk_fwd, hipFuncAttributeMaxDynamicSharedMemorySize, LDS_BYTES) != hipSuccess) { fprintf(stderr, "kernel_launch: hipFuncSetAttribute failed\n"); grid = -1; return; }
        int per_cu = 0;
        if (hipOccupancyMaxActiveBlocksPerMultiprocessor(&per_cu, (const void*)mk_fwd, NWAVES * 64, LDS_BYTES) != hipSuccess || per_cu < 1)
            fprintf(stderr, "kernel_launch: note: occupancy query reports %d workgroups per CU\n", per_cu);
        (void)hipGetLastError();
        grid = cus;
    }
    if (grid < 0) return;
    if (hipMemsetAsync((char*)d_ws + WS_CTL, 0, CTL_ZERO_BYTES, stream) != hipSuccess) return;
    Args a{};
    for (int i = 0; i < 25; ++i) a.in[i] = (const float*)d_in[i];
    a.out = (float*)d_out; a.ws = (unsigned char*)d_ws;
    hipLaunchKernelGGL(mk_fwd, dim3(grid), dim3(NWAVES * 64), LDS_BYTES, stream, a);
    const hipError_t le = hipPeekAtLastError();
    if (le != hipSuccess) fprintf(stderr, "kernel_launch: launch failed: %s\n", hipGetErrorName(le));
}
```
